# Optimizing an MI355X kernel written in HIP

```python
import math
import jax, jax.numpy as jnp
from jax import lax
import numpy as np

D_MODEL = 1024
BATCH = 4
SEQ = 4096
DEPTH = 2

GRID_W = 64
CTX_LEN = 256
D_FF = 2816
N_MOD = 9
EPS = 1e-6

HY_C = 256
HY_GROUPS = 4
HY_ORDER = 2
HY_BANDS = 16
HY_EMB = 1 + 2 * HY_BANDS
HY_FFN = 64
HY_DECAY_TARGET = 1e-2
HY_FAST_PCT = 0.3
HY_SLOW_PCT = 1.5
HY_WINDOW_SHIFT = 0.05

SG_C = 256
SG_GROUPS = 4
SG_CHUNK = 128

MLA_HEADS = 8
MLA_NOPE = 64
MLA_ROPE = 32
MLA_V = 64
MLA_Q_RANK = 384
MLA_KV_RANK = 256
MLA_SCALE = (MLA_NOPE + MLA_ROPE) ** -0.5
ROPE_BASE = 10000.0
Q_BLOCK = 128

MIX_WIDTH = HY_C + SG_C + MLA_HEADS * MLA_V
OFF_SG = 3 * HY_C
OFF_Q = OFF_SG + 2 * SG_C
OFF_KV = OFF_Q + MLA_Q_RANK
OFF_KR = OFF_KV + MLA_KV_RANK
N_IN = OFF_KR + MLA_ROPE

kernel_name = "hybrid_hyena_sgu_mla_dit_trunk"


def rms(x):
    xf = x.astype(jnp.float32)
    return (xf * lax.rsqrt(jnp.mean(xf * xf, axis=-1, keepdims=True) + EPS)).astype(x.dtype)


def layer_norm(x, g, b):
    xf = x.astype(jnp.float32)
    mu = jnp.mean(xf, axis=-1, keepdims=True)
    var = jnp.mean(jnp.square(xf - mu), axis=-1, keepdims=True)
    return ((xf - mu) * lax.rsqrt(var + EPS)).astype(x.dtype) * g + b


def modulate(x, shift, scale):
    return rms(x) * (1 + scale) + shift


def swiglu(h, wg, wu, wd):
    return (jax.nn.silu(h @ wg) * (h @ wu)) @ wd


def short_conv(u, w, b):
    L = u.shape[1]
    up = jnp.pad(u, ((0, 0), (1, 1), (0, 0)))
    return up[:, 0:L] * w[0] + up[:, 1:L + 1] * w[1] + up[:, 2:L + 2] * w[2] + b


def hyena_filters(L, w1, b1, w2, b2, w3, freq):
    pos = jnp.arange(L, dtype=jnp.float32)
    t = pos / max(L - 1, 1)
    w = 2.0 * math.pi * pos / L
    bands = jnp.linspace(1e-4, HY_BANDS - 1, HY_BANDS, dtype=jnp.float32)
    ang = w[:, None] * bands[None, :]
    z = jnp.concatenate([t[:, None], jnp.cos(ang), -jnp.sin(ang)], axis=-1).astype(w1.dtype)
    h = jnp.sin(freq[0] * (z @ w1 + b1))
    h = jnp.sin(freq[1] * (h @ w2 + b2))
    h = (h @ w3).reshape(L, HY_ORDER, 2, HY_C)
    min_decay = abs(math.log(HY_DECAY_TARGET) / HY_SLOW_PCT)
    max_decay = abs(math.log(HY_DECAY_TARGET) / HY_FAST_PCT)
    deltas = jnp.linspace(min_decay, max_decay, HY_C, dtype=jnp.float32)
    window = jnp.exp(-t[:, None, None, None] * deltas) + HY_WINDOW_SHIFT
    return h * window.astype(h.dtype)


def bidir_fftconv(u, h_fwd, h_bwd):
    L = u.shape[1]
    k = jnp.concatenate([h_fwd[:1] + h_bwd[:1], h_fwd[1:], jnp.zeros_like(h_fwd[:1]), h_bwd[:0:-1]], axis=0)
    uf = jnp.fft.rfft(u.astype(jnp.float32), n=2 * L, axis=1)
    kf = jnp.fft.rfft(k.astype(jnp.float32), n=2 * L, axis=0)
    y = jnp.fft.irfft(uf * kf[None], n=2 * L, axis=1)[:, :L]
    return y.astype(u.dtype)


def hyena_mixer(p3, conv_w, conv_b, filt, bias):
    z = short_conv(p3, conv_w, conv_b)
    x1, x2, v = jnp.split(z, 3, axis=-1)
    gates = (x1, x2)
    for o in range(HY_ORDER):
        v = gates[o] * (bidir_fftconv(v, filt[:, o, 0], filt[:, o, 1]) + v * bias[o])
    return v


def chunk_sgu(p2, ln_g, ln_b, w_s, b_s):
    z = jax.nn.gelu(p2, approximate=False)
    u, v = jnp.split(z, 2, axis=-1)
    v = layer_norm(v, ln_g, ln_b)
    B, L, _ = v.shape
    v = v.reshape(B, L // SG_CHUNK, SG_CHUNK, SG_GROUPS, SG_C // SG_GROUPS)
    s = jnp.einsum('gpq,bnqgc->bnpgc', w_s, v) + b_s.T[None, None, :, :, None]
    return u * s.reshape(B, L, SG_C)


def axial_rope_tables(n):
    n_rows = n // GRID_W
    rows = jnp.repeat(jnp.arange(n_rows, dtype=jnp.float32), GRID_W)
    cols = jnp.tile(jnp.arange(GRID_W, dtype=jnp.float32), n_rows)
    quarter = MLA_ROPE // 4
    inv = 1.0 / (ROPE_BASE ** (jnp.arange(quarter, dtype=jnp.float32) / quarter))
    ang = jnp.stack([rows[:, None] * inv, cols[:, None] * inv], axis=1)
    return jnp.cos(ang), jnp.sin(ang)


def apply_axial_rope(x, cos, sin):
    shp = x.shape
    quarter = MLA_ROPE // 4
    xr = x.reshape(shp[:-1] + (2, 2, quarter))
    x1, x2 = xr[..., 0, :], xr[..., 1, :]
    bshape = (shp[1],) + (1,) * (x.ndim - 3) + (2, quarter)
    c = cos.reshape(bshape).astype(x.dtype)
    s = sin.reshape(bshape).astype(x.dtype)
    return jnp.stack([x1 * c - x2 * s, x2 * c + x1 * s], axis=-2).reshape(shp)


def mla_q(cq, g, w_uq):
    B, n, _ = cq.shape
    q = ((rms(cq) * g) @ w_uq).reshape(B, n, MLA_HEADS, MLA_NOPE + MLA_ROPE)
    return q[..., :MLA_NOPE], q[..., MLA_NOPE:]


def mla_kv(ckv, g, w_ukv):
    B, n, _ = ckv.shape
    kv = ((rms(ckv) * g) @ w_ukv).reshape(B, n, MLA_HEADS, MLA_NOPE + MLA_V)
    return kv[..., :MLA_NOPE], kv[..., MLA_NOPE:]


def attend(q_nope, q_rope, k_nope, k_rope, v):
    s = jnp.einsum('bqhd,bkhd->bhqk', q_nope, k_nope) + jnp.einsum('bqhr,bkr->bhqk', q_rope, k_rope)
    p = jax.nn.softmax(s.astype(jnp.float32) * MLA_SCALE, axis=-1).astype(v.dtype)
    return jnp.einsum('bhqk,bkhd->bqhd', p, v)


def attend_blocks(q_nope, q_rope, k_nope, k_rope, v):
    B, n = q_nope.shape[:2]
    nb = n // Q_BLOCK

    def to_blocks(t):
        return t.reshape((B, nb, Q_BLOCK) + t.shape[2:]).swapaxes(0, 1)

    out = lax.map(lambda qs: attend(qs[0], qs[1], k_nope, k_rope, v), (to_blocks(q_nope), to_blocks(q_rope)))
    return out.swapaxes(0, 1).reshape(B, n, MLA_HEADS * MLA_V)


def setup_inputs(seed: int = 0) -> dict:
    key = jax.random.key(seed)
    ks = iter(jax.random.split(key, 40))

    def nrm(shape, scale):
        return scale * jax.random.normal(next(ks), shape, jnp.float32)

    D = D_MODEL
    return {
        "x": nrm((BATCH, SEQ, D), 1.0),
        "c": nrm((BATCH, D), 1.0),
        "ctx": nrm((BATCH, CTX_LEN, D), 1.0),
        "c_ctx": nrm((D,), 1.0),
        "ada_w": nrm((DEPTH, D, N_MOD * D), 0.5 * D ** -0.5),
        "ada_b": nrm((DEPTH, N_MOD * D), 0.02),
        "ffn1_wg": nrm((DEPTH, D, D_FF), D ** -0.5),
        "ffn1_wu": nrm((DEPTH, D, D_FF), D ** -0.5),
        "ffn1_wd": nrm((DEPTH, D_FF, D), D_FF ** -0.5),
        "w_in": nrm((DEPTH, D, N_IN), D ** -0.5),
        "w_out": nrm((DEPTH, MIX_WIDTH, D), MIX_WIDTH ** -0.5),
        "hy_conv_w": nrm((DEPTH, 3, 3 * HY_C), 3 ** -0.5),
        "hy_conv_b": nrm((DEPTH, 3 * HY_C), 0.02),
        "hy_w1": nrm((DEPTH, HY_EMB, HY_FFN), 2.0 * HY_EMB ** -0.5),
        "hy_b1": nrm((DEPTH, HY_FFN), 0.1),
        "hy_w2": nrm((DEPTH, HY_FFN, HY_FFN), 2.0 * HY_FFN ** -0.5),
        "hy_b2": nrm((DEPTH, HY_FFN), 0.1),
        "hy_w3": nrm((DEPTH, HY_FFN, HY_ORDER * 2 * HY_C), 0.005),
        "hy_freq": 1.0 + nrm((DEPTH, 2, HY_FFN), 0.1),
        "hy_bias": nrm((DEPTH, HY_ORDER, HY_C), 0.2),
        "sg_ln_g": 1.0 + nrm((DEPTH, SG_C), 0.05),
        "sg_ln_b": nrm((DEPTH, SG_C), 0.02),
        "sg_w": nrm((DEPTH, SG_GROUPS, SG_CHUNK, SG_CHUNK), 0.5 * SG_CHUNK ** -0.5),
        "sg_b": 1.0 + nrm((DEPTH, SG_GROUPS, SG_CHUNK), 0.1),
        "mla_q_norm": 1.0 + nrm((DEPTH, MLA_Q_RANK), 0.05),
        "mla_w_uq": nrm((DEPTH, MLA_Q_RANK, MLA_HEADS * (MLA_NOPE + MLA_ROPE)), MLA_Q_RANK ** -0.5),
        "mla_kv_norm": 1.0 + nrm((DEPTH, MLA_KV_RANK), 0.05),
        "mla_w_ukv": nrm((DEPTH, MLA_KV_RANK, MLA_HEADS * (MLA_NOPE + MLA_V)), MLA_KV_RANK ** -0.5),
        "ffn2_wg": nrm((DEPTH, D, D_FF), D ** -0.5),
        "ffn2_wu": nrm((DEPTH, D, D_FF), D ** -0.5),
        "ffn2_wd": nrm((DEPTH, D_FF, D), D_FF ** -0.5),
        "final_norm": 1.0 + nrm((D,), 0.05),
    }


def reference(x, c, ctx, c_ctx, ada_w, ada_b, ffn1_wg, ffn1_wu, ffn1_wd, w_in, w_out,
              hy_conv_w, hy_conv_b, hy_w1, hy_b1, hy_w2, hy_b2, hy_w3, hy_freq, hy_bias,
              sg_ln_g, sg_ln_b, sg_w, sg_b, mla_q_norm, mla_w_uq, mla_kv_norm, mla_w_ukv,
              ffn2_wg, ffn2_wu, ffn2_wd, final_norm):
    B, n_lat, D = x.shape
    n_ctx = ctx.shape[1]
    cos, sin = axial_rope_tables(n_lat)
    xc = ctx
    for l in range(DEPTH):
        last = l == DEPTH - 1
        mod = (jax.nn.silu(c) @ ada_w[l] + ada_b[l]).reshape(B, N_MOD, 1, D)
        modc = (jax.nn.silu(c_ctx) @ ada_w[l] + ada_b[l]).reshape(N_MOD, D)

        x = x + 0.5 * mod[:, 2] * swiglu(modulate(x, mod[:, 0], mod[:, 1]), ffn1_wg[l], ffn1_wu[l], ffn1_wd[l])
        xc = xc + 0.5 * modc[2] * swiglu(modulate(xc, modc[0], modc[1]), ffn1_wg[l], ffn1_wu[l], ffn1_wd[l])

        h = modulate(x, mod[:, 3], mod[:, 4])
        hc = modulate(xc, modc[3], modc[4])
        proj = h @ w_in[l]
        projc = hc @ (w_in[l][:, OFF_KV:] if last else w_in[l])

        kc_nope, vc = mla_kv(projc[..., -(MLA_KV_RANK + MLA_ROPE):-MLA_ROPE], mla_kv_norm[l], mla_w_ukv[l])
        kc_rope = projc[..., -MLA_ROPE:]

        k_nope, v = mla_kv(proj[..., OFF_KV:OFF_KR], mla_kv_norm[l], mla_w_ukv[l])
        k_rope = apply_axial_rope(proj[..., OFF_KR:N_IN], cos, sin)
        q_nope, q_rope = mla_q(proj[..., OFF_Q:OFF_KV], mla_q_norm[l], mla_w_uq[l])
        q_rope = apply_axial_rope(q_rope, cos, sin)
        y_attn = attend_blocks(q_nope, q_rope,
                               jnp.concatenate([kc_nope, k_nope], axis=1),
                               jnp.concatenate([kc_rope, k_rope], axis=1),
                               jnp.concatenate([vc, v], axis=1))
        filt = hyena_filters(n_lat, hy_w1[l], hy_b1[l], hy_w2[l], hy_b2[l], hy_w3[l], hy_freq[l])
        y_hy = hyena_mixer(proj[..., :OFF_SG], hy_conv_w[l], hy_conv_b[l], filt, hy_bias[l])
        y_sg = chunk_sgu(proj[..., OFF_SG:OFF_Q], sg_ln_g[l], sg_ln_b[l], sg_w[l], sg_b[l])
        x = x + mod[:, 5] * (jnp.concatenate([y_hy, y_sg, y_attn], axis=-1) @ w_out[l])

        if not last:
            filt_c = hyena_filters(n_ctx, hy_w1[l], hy_b1[l], hy_w2[l], hy_b2[l], hy_w3[l], hy_freq[l])
            yc_hy = hyena_mixer(projc[..., :OFF_SG], hy_conv_w[l], hy_conv_b[l], filt_c, hy_bias[l])
            yc_sg = chunk_sgu(projc[..., OFF_SG:OFF_Q], sg_ln_g[l], sg_ln_b[l], sg_w[l], sg_b[l])
            qc_nope, qc_rope = mla_q(projc[..., OFF_Q:OFF_KV], mla_q_norm[l], mla_w_uq[l])
            yc_attn = attend(qc_nope, qc_rope, kc_nope, kc_rope, vc).reshape(B, n_ctx, MLA_HEADS * MLA_V)
            xc = xc + modc[5] * (jnp.concatenate([yc_hy, yc_sg, yc_attn], axis=-1) @ w_out[l])

        x = x + 0.5 * mod[:, 8] * swiglu(modulate(x, mod[:, 6], mod[:, 7]), ffn2_wg[l], ffn2_wu[l], ffn2_wd[l])
        if not last:
            xc = xc + 0.5 * modc[8] * swiglu(modulate(xc, modc[6], modc[7]), ffn2_wg[l], ffn2_wu[l], ffn2_wd[l])
    return rms(x) * final_norm
```

```cpp
#include <hip/hip_runtime.h>
#include <hip/hip_cooperative_groups.h>
#include <cstdio>
namespace cg = cooperative_groups;

#define LAS __attribute__((address_space(3)))
#define DI __device__ __forceinline__
typedef unsigned short bf16_t;
typedef short bf16x8 __attribute__((ext_vector_type(8)));
typedef short s16x4 __attribute__((ext_vector_type(4)));
typedef float f32x4 __attribute__((ext_vector_type(4)));
typedef float f32x2 __attribute__((ext_vector_type(2)));
typedef float f32x16 __attribute__((ext_vector_type(16)));
typedef unsigned u32x4 __attribute__((ext_vector_type(4)));
typedef unsigned u32x2 __attribute__((ext_vector_type(2)));
typedef __bf16 bf16x2_t __attribute__((ext_vector_type(2)));

struct Params { const float* in[32]; float* out; char* ws; };

constexpr int NLAT = 16384, MTOT = 17408, DM = 1024, DFF = 2816, NIN = 1952, NINP = 2048, NPOS = 4352;
enum { I_X = 0, I_C, I_CTX, I_CCTX, I_ADAW, I_ADAB, I_F1G, I_F1U, I_F1D, I_WIN, I_WOUT, I_HCW, I_HCB, I_HW1, I_HB1, I_HW2, I_HB2, I_HW3, I_HFREQ, I_HBIAS,
       I_SGG, I_SGB, I_SGW, I_SGBS, I_QN, I_WUQ, I_KVN, I_WUKV, I_F2G, I_F2U, I_F2D, I_FN };
constexpr size_t OFF_XC = 0;
constexpr size_t OFF_H = OFF_XC + (size_t)1024 * 1024 * 4;
constexpr size_t OFF_R1 = OFF_H + (size_t)MTOT * 1024 * 2;
constexpr size_t OFF_PROJ = OFF_R1;
constexpr size_t OFF_PT = OFF_PROJ + (size_t)MTOT * NINP * 2;
constexpr size_t OFF_PTC = OFF_PT + (size_t)4 * 768 * 4096 * 2;
constexpr size_t OFF_Q = OFF_PROJ;
constexpr size_t OFF_KN = OFF_Q + (size_t)32 * NPOS * 96 * 2;
constexpr size_t OFF_VT = OFF_KN + (size_t)32 * NPOS * 64 * 2;
constexpr size_t OFF_R2 = OFF_R1 + (size_t)MTOT * DFF * 2;
constexpr size_t OFF_PART = OFF_R2;
constexpr size_t OFF_CQN = OFF_R2;
constexpr size_t OFF_CKVN = OFF_CQN + (size_t)MTOT * 384 * 2;
constexpr size_t OFF_KR = OFF_CKVN + (size_t)MTOT * 256 * 2;
constexpr size_t OFF_UG = OFF_KR + (size_t)4 * NPOS * 32 * 2;
constexpr size_t OFF_VN = OFF_UG + (size_t)MTOT * 256 * 2;
constexpr size_t OFF_W = OFF_VN + (size_t)MTOT * 256 * 2;
constexpr size_t WO_UP1 = 0, WO_UP2 = 5767168, WO_D1 = 11534336, WO_D2 = 14417920, WO_IN = 17301504, WO_OUT = 19398656, WO_UQ = 20447232, WO_UKV = 20742144, WO_S = 21004288, WL_ELEMS = 21069824;
constexpr size_t OFF_MOD = OFF_W + 2 * WL_ELEMS * 2;
constexpr size_t OFF_H2 = OFF_MOD + (size_t)2 * 5 * 9216 * 4;
constexpr size_t OFF_H2C = OFF_H2 + (size_t)2 * 4096 * 64 * 4;
constexpr size_t OFF_TW = OFF_H2C + (size_t)2 * 256 * 64 * 4;
constexpr size_t OFF_ROPE = OFF_TW + 4096 * 8;
constexpr size_t OFF_XB = OFF_ROPE + 64 * 8 * 8;
constexpr size_t OFF_BAR = OFF_XB + (size_t)NLAT * 1024 * 2;
constexpr size_t WS_END = OFF_BAR + 16384;
static_assert(OFF_VT + (size_t)32 * NPOS * 64 * 2 <= OFF_PT, "alias overflow");
static_assert(OFF_PTC + (size_t)4 * 768 * 256 * 2 <= OFF_R2, "R1 overflow");

DI int otid(int wv) { int ln; asm volatile("v_mbcnt_lo_u32_b32 %0, -1, 0\n\tv_mbcnt_hi_u32_b32 %0, -1, %0" : "=&v"(ln)); return (wv << 6) | ln; }
DI unsigned pk_bf16(float a, float b) { f32x2 v = {a, b}; bf16x2_t r = __builtin_convertvector(v, bf16x2_t); return __builtin_bit_cast(unsigned, r); }
DI bf16_t f2bf(float a) { return (bf16_t)(pk_bf16(a, a) & 0xffffu); }
DI float bf2f(bf16_t u) { return __uint_as_float(((unsigned)u) << 16); }
DI float silu_f(float g) { return g * __builtin_amdgcn_rcpf(1.f + __expf(-g)); }
typedef __attribute__((address_space(1))) char gchar;
DI gchar* ows(const Params& P) {
  const unsigned long long w = (unsigned long long)P.ws; unsigned lo = (unsigned)w, hi = (unsigned)(w >> 32);
  asm volatile("" : "+v"(lo), "+v"(hi));
  lo = __builtin_amdgcn_readfirstlane(lo); hi = __builtin_amdgcn_readfirstlane(hi);
  return (gchar*)(((unsigned long long)hi << 32) | lo);
}
DI float rdlane_c(float v, int i) { return __builtin_bit_cast(float, __builtin_amdgcn_readlane(__builtin_bit_cast(int, v), i)); }
DI float xshfl(float v, int lane, int o) { return __builtin_bit_cast(float, __builtin_amdgcn_ds_bpermute((lane ^ o) << 2, __builtin_bit_cast(int, v))); }
#define DPP_F(v, ctrl) __builtin_bit_cast(float, __builtin_amdgcn_update_dpp(0, __builtin_bit_cast(int, (v)), (ctrl), 0xf, 0xf, true))
DI float wave_sum(float v, int lane) {
  v += DPP_F(v, 0xB1); v += DPP_F(v, 0x4E); v += DPP_F(v, 0x141); v += DPP_F(v, 0x140);
  return (rdlane_c(v, 0) + rdlane_c(v, 16)) + (rdlane_c(v, 32) + rdlane_c(v, 48));
}
DI float gelu_f(float v) {
  const float av = __builtin_fabsf(v), t = __builtin_amdgcn_rcpf(av * 0.2316418882f + 1.0f);
  float q = t * 0.5307027145f + (-0.7265760135f); q = q * t + 0.7107068705f; q = q * t + (-0.142248368f); q = q * t + 0.127414796f; q = q * t;
  const float e = __builtin_amdgcn_exp2f((v * v) * (-0.72134752044f)), m = v * (q * e);
  return v < 0.f ? m : v - m;
}
DI float rdlane(float v, int i) { return __builtin_bit_cast(float, __builtin_amdgcn_readlane(__builtin_bit_cast(int, v), i)); }
DI void row_bp(int r, int& b, int& p) { if (r < NLAT) { b = r >> 12; p = 256 + (r & 4095); } else { const int rc = r - NLAT; b = rc >> 8; p = rc & 255; } }
DI f32x4 bf4_to_f32(u32x2 w) { return (f32x4){__uint_as_float(w.x << 16), __uint_as_float(w.x & 0xffff0000u), __uint_as_float(w.y << 16), __uint_as_float(w.y & 0xffff0000u)}; }
DI u32x2 f32_to_bf4(f32x4 v) { u32x2 w; w.x = pk_bf16(v[0], v[1]); w.y = pk_bf16(v[2], v[3]); return w; }
DI f32x4 xload(const Params& P, int r, int c) {
  if (r < NLAT) return bf4_to_f32(*(const u32x2*)((const bf16_t*)(ows(P) + OFF_XB) + (size_t)r * 1024 + c));
  return *(const f32x4*)((const float*)(ows(P) + OFF_XC) + (size_t)(r - NLAT) * 1024 + c);
}
DI void xstore(const Params& P, int r, int c, f32x4 v) {
  if (r < NLAT) *(u32x2*)((bf16_t*)(ows(P) + OFF_XB) + (size_t)r * 1024 + c) = f32_to_bf4(v);
  else *(f32x4*)((float*)(ows(P) + OFF_XC) + (size_t)(r - NLAT) * 1024 + c) = v;
}

#define XB_TMO      128
#define XB_XCNT(j)  (256  + 64 * (j))
#define XB_XSUB(j)  (1280 + 64 * (j))
#define XB_XGEN(j)  (2304 + 64 * (j))
#define XB_TOP      3328
#define XB_TOPGEN   3392
#define XCD_BAR_WORDS 3456
#define XB_SPIN_CAP (1u << 20)
constexpr int LDS_ST_OFF = 133120;
constexpr int LDS_TW2_OFF = 133632;
DI unsigned xb_ld(unsigned* p) { return __hip_atomic_load(p, __ATOMIC_RELAXED, __HIP_MEMORY_SCOPE_AGENT); }
DI unsigned xb_add(unsigned* p, unsigned v) { return __hip_atomic_fetch_add(p, v, __ATOMIC_RELAXED, __HIP_MEMORY_SCOPE_AGENT); }
DI unsigned xb_xcc_id() { return (unsigned)__builtin_amdgcn_s_getreg((3 << 11) | 20) & 0xFu; }
#define XB_SPIN(cond, bar) do { unsigned _sp = 0; while (cond) { __builtin_amdgcn_s_sleep(1); \
    if ((++_sp & 255u) == 0u) { if (xb_ld(&(bar)[XB_TMO])) break; if (_sp > XB_SPIN_CAP) { atomicAdd(&(bar)[XB_TMO], 1u); break; } } } } while (0)
DI void xcd_barrier_complete(unsigned* bar, unsigned x, unsigned& nloc, unsigned& nx) {
  const unsigned G = gridDim.x;
  unsigned sum, cnt, mine, sp = 0u;
  for (;;) {
    sum = 0u; cnt = 0u; mine = 0u;
#pragma unroll
    for (unsigned j = 0; j < 16; ++j) { const unsigned c = xb_ld(&bar[XB_XCNT(j)]); sum += c; cnt += (c > 0u) ? 1u : 0u; mine = (j == x) ? c : mine; }
    if (sum == G) break;
    __builtin_amdgcn_s_sleep(1);
    if ((++sp & 255u) == 0u) { if (xb_ld(&bar[XB_TMO])) break; if (sp > XB_SPIN_CAP) { atomicAdd(&bar[XB_TMO], 1u); break; } }
  }
  nloc = mine > 0u ? mine : 1u; nx = cnt > 0u ? cnt : 1u;
}
DI void gsync(const Params& P, unsigned char* lds, int wv) {
  asm volatile("s_waitcnt vmcnt(0)" ::: "memory");
  __syncthreads();
  if (wv == 0 && __builtin_amdgcn_mbcnt_lo(~0u, 0u) == 0 && __builtin_amdgcn_mbcnt_hi(~0u, 0u) == 0) {
    unsigned* bar = (unsigned*)(ows(P) + OFF_BAR);
    volatile LAS unsigned* st = (volatile LAS unsigned*)((LAS unsigned char*)lds + LDS_ST_OFF);
    const unsigned x = xb_xcc_id();
    __builtin_amdgcn_s_waitcnt(0);
    unsigned nloc = st[0], nx = st[1];
    if (nloc == 0u) { xcd_barrier_complete(bar, x, nloc, nx); st[0] = nloc; st[1] = nx; }
    const unsigned old = xb_add(&bar[XB_XSUB(x)], 1u);
    const unsigned gen = old / nloc;
    if (old + 1u == (gen + 1u) * nloc) {
      __builtin_amdgcn_fence(__ATOMIC_RELEASE, "agent");
      asm volatile("s_waitcnt vmcnt(0)" ::: "memory");
      const unsigned og = xb_add(&bar[XB_TOP], 1u);
      const unsigned tg = og / nx;
      if (og + 1u == (tg + 1u) * nx) xb_add(&bar[XB_TOPGEN], 1u);
      else XB_SPIN(xb_ld(&bar[XB_TOPGEN]) == tg, bar);
      __builtin_amdgcn_fence(__ATOMIC_ACQUIRE, "agent");
      xb_add(&bar[XB_XGEN(x)], 1u);
      asm volatile("s_waitcnt vmcnt(0)" ::: "memory");
    } else {
      XB_SPIN(xb_ld(&bar[XB_XGEN(x)]) == gen, bar);
      __builtin_amdgcn_fence(__ATOMIC_ACQUIRE, "agent");
      asm volatile("s_waitcnt vmcnt(0)" ::: "memory");
    }
  }
  __syncthreads();
}
namespace pg8 {
#define PG8_LAS __attribute__((address_space(3)))
constexpr int BM = 256, BK = 64, HALF = 128, HTB = HALF * BK * 2  , STAGE_BYTES = 8 * HTB, NXCD = 8, WGM = 4;
__host__ __device__ __forceinline__ int lds_byte(int r, int c) { const int st = (r >> 4) * 2 + (c >> 5), rr = r & 15, cc = c & 31, ob = rr * 64 + cc * 2; return st * 1024 + (ob ^ (((ob >> 9) & 1) << 5)); }
__host__ __device__ __forceinline__ void stage_rc(int b, int& R, int& C) { const int st = b / 1024, sb = b % 1024, swz = sb ^ (((sb >> 9) & 1) << 5); R = (st >> 1) * 16 + swz / 64; C = (st & 1) * 32 + (swz % 64) / 2; }
__host__ __device__ __forceinline__ int perm32(int rho) { const int n = rho >> 4, i = rho & 15; return 8 * (i >> 2) + 4 * n + (i & 3); }

struct Unit { int pm, pn, koff, nt; };
struct Gemm { const bf16_t* A; const bf16_t* Bt; int M, N, K; };
struct StaticOrder {
    int nM, nN, nwg, G, c, ntk;
    __host__ __device__ void init(int M, int N, int G_, int c_) { nM = M / BM; nN = N / BM; nwg = nM * nN; G = G_; c = c_; }
    __host__ __device__ bool next(int i, Unit& u) const {
        const long L = (long)i * G + c; if (L >= nwg) return false;
        int wgid = (int)L; { const int q = nwg / NXCD, r = nwg % NXCD, xcd = wgid % NXCD, off = wgid / NXCD; wgid = (xcd < r ? xcd * (q + 1) : r * (q + 1) + (xcd - r) * q) + off; }
        const int nig = WGM * nN, gid = wgid / nig, fm = gid * WGM, gsz = (nM - fm) < WGM ? (nM - fm) : WGM;
        u.pm = fm + ((wgid % nig) % gsz); u.pn = (wgid % nig) / gsz; u.koff = 0; u.nt = ntk; return true;
    }
    __device__ __forceinline__ void a_ready(const Unit&) const {}
    __device__ __forceinline__ void done(const Unit&) const {}
};
struct SplitOrder {
    StaticOrder lat; int S, ksub, rounds, uneven;
    __device__ void init(int K, int S_, int G_, int c_) { lat.init(16384, 1024, G_, c_); lat.ntk = K / BK; S = S_; ksub = K / S_; rounds = (lat.nwg + G_ - 1) / G_; uneven = (K == 2816 && S_ == 8); }
    __device__ bool next(int i, Unit& u) const {
        const int nlat = lat.c < lat.nwg ? (lat.nwg - lat.c + lat.G - 1) / lat.G : 0;
        if (i < nlat) return lat.next(i, u);
        const int e = (i - nlat) * lat.G + lat.c; if (e >= 16 * S) return false;
        const int j = e / S, s = e - j * S; u.pm = 64 + (j >> 2); u.pn = j & 3;
        if (uneven) { const int q4 = s >> 2, r4 = s & 3; u.koff = (q4 * 22 + r4 * 6) * BK; u.nt = r4 == 3 ? 4 : 6; }
        else { u.koff = s * ksub; u.nt = ksub / BK; }
        return true;
    }
    __device__ __forceinline__ void a_ready(const Unit&) const {}
    __device__ __forceinline__ void done(const Unit&) const {}
};
template <class Epi, class Sched, bool STAMP = false>
__device__ __forceinline__ void gemm_phase(PG8_LAS unsigned char* lds, const Gemm g, const Sched& S, const Epi& E, unsigned long long* stamps, int wv) {
    const int tid = otid(wv), wid = __builtin_amdgcn_readfirstlane(tid >> 6), lane = tid & 63, wr = wid >> 2, wc = wid & 3, fr = lane & 15, fq = lane >> 4;
    const int K = g.K;
#define PG8_STAMP() do {} while (0)
    unsigned voffA[2], voffB[2];
#pragma unroll
    for (int i = 0; i < 2; ++i) { int R, C; stage_rc(tid * 16 + i * 8192, R, C); const int Rb = Epi::PERM ? ((R & ~31) + perm32(R & 31)) : R;
        voffA[i] = (unsigned)(R * K + C) * 2u; voffB[i] = (unsigned)(Rb * K + C) * 2u; }
    const size_t kstep = (size_t)(BK * 2);
    const size_t hstep = (size_t)HALF * K * 2;
    const size_t tstep = 2 * hstep;
    const unsigned ldsw = (unsigned)wid * 1024u;
    const int aoff = lds_byte(wr * 64 + fr, fq * 8), boff = lds_byte(wc * 32 + fr, fq * 8);
#define PG8_SA(b, h) (((b) * 2 + (h)) * HTB)
#define PG8_SB(b, h) ((4 + (b) * 2 + (h)) * HTB)
#define PG8_STAGE(bufoff, gbase, voff) do { _Pragma("unroll") for (int _i = 0; _i < 2; ++_i) \
        __builtin_amdgcn_global_load_lds((const unsigned*)((const char*)(gbase) + (voff)[_i]), (PG8_LAS unsigned*)(lds + (bufoff) + ldsw + _i * 8192), 16, 0, 0); } while (0)
#define PG8_LDA(dst, b, h) do { _Pragma("unroll") for (int m = 0; m < 4; ++m) _Pragma("unroll") for (int k = 0; k < 2; ++k) dst[m][k] = *(const PG8_LAS bf16x8*)(lds + PG8_SA(b, h) + aoff + m * 2048 + k * 1024); } while (0)
#define PG8_LDB(dst, b, h) do { _Pragma("unroll") for (int n = 0; n < 2; ++n) _Pragma("unroll") for (int k = 0; k < 2; ++k) dst[n][k] = *(const PG8_LAS bf16x8*)(lds + PG8_SB(b, h) + boff + n * 2048 + k * 1024); } while (0)
#define PG8_MMA(ai, bj, At, Bt) do { __builtin_amdgcn_s_setprio(1); _Pragma("unroll") for (int m = 0; m < 4; ++m) _Pragma("unroll") for (int n = 0; n < 2; ++n) _Pragma("unroll") for (int k = 0; k < 2; ++k) \
        acc[ai][bj][m][n] = __builtin_amdgcn_mfma_f32_16x16x32_bf16(Bt[n][k], At[m][k], acc[ai][bj][m][n], 0, 0, 0); __builtin_amdgcn_s_setprio(0); } while (0)
#define PG8_WAIT_V(n) asm volatile("s_waitcnt vmcnt(" #n ")" ::: "memory")
#define PG8_WAIT_L(n) asm volatile("s_waitcnt lgkmcnt(" #n ")" ::: "memory")
#define PG8_BAR __builtin_amdgcn_s_barrier()
#define PG8_SCHED __builtin_amdgcn_sched_barrier(0)
    Unit cur, nxt; int ui = 0;
    if (!S.next(0, cur)) return;
    f32x4 acc[2][2][4][2];
#pragma unroll
    for (int a = 0; a < 2; ++a)
#pragma unroll
        for (int b = 0; b < 2; ++b)
#pragma unroll
            for (int m = 0; m < 4; ++m)
#pragma unroll
                for (int n = 0; n < 2; ++n) acc[a][b][m][n] = (f32x4){0.f, 0.f, 0.f, 0.f};
    bf16x8 At[4][2], B0[2][2], B1[2][2];
    const char* cA = (const char*)g.A + (size_t)cur.pm * tstep + (size_t)cur.koff * 2; const char* cB = (const char*)g.Bt + (size_t)cur.pn * tstep + (size_t)cur.koff * 2;
    S.a_ready(cur);
    PG8_STAGE(PG8_SB(0, 0), cB, voffB); PG8_STAGE(PG8_SA(0, 0), cA, voffA); PG8_STAGE(PG8_SB(0, 1), cB + hstep, voffB); PG8_STAGE(PG8_SA(0, 1), cA + hstep, voffA);
    if (wr == 1) PG8_BAR;
    PG8_WAIT_V(4); PG8_BAR;
    PG8_STAGE(PG8_SB(1, 0), cB + kstep, voffB); PG8_STAGE(PG8_SA(1, 0), cA + kstep, voffA); PG8_STAGE(PG8_SB(1, 1), cB + hstep + kstep, voffB);
    PG8_WAIT_V(6); PG8_BAR;
    for (;;) {
        const bool has_next = S.next(ui + 1, nxt);
        const char* nA = has_next ? (const char*)g.A + (size_t)nxt.pm * tstep + (size_t)nxt.koff * 2 : cA; const char* nB = has_next ? (const char*)g.Bt + (size_t)nxt.pn * tstep + (size_t)nxt.koff * 2 : cB;
        const int nt = cur.nt;
        for (int t = 0; t < nt; t += 2) {
            const bool last = (t == nt - 2);
            const char* a1 = cA + (size_t)(t + 1) * kstep;
            const char* a2 = last ? nA : cA + (size_t)(t + 2) * kstep; const char* b2 = last ? nB : cB + (size_t)(t + 2) * kstep;
            const char* a3 = a2 + kstep; const char* b3 = b2 + kstep;
            if (last && has_next) S.a_ready(nxt);
            PG8_LDB(B0, 0, 0); PG8_SCHED; PG8_LDA(At, 0, 0); PG8_STAGE(PG8_SA(1, 1), a1 + hstep, voffA);
            PG8_WAIT_L(8); PG8_BAR; PG8_WAIT_L(0); PG8_MMA(0, 0, At, B0); PG8_BAR; PG8_SCHED;
            PG8_LDB(B1, 0, 1); PG8_STAGE(PG8_SB(0, 0), b2, voffB);
            PG8_BAR; PG8_WAIT_L(0); PG8_MMA(0, 1, At, B1); PG8_BAR;
            PG8_LDA(At, 0, 1); PG8_STAGE(PG8_SA(0, 0), a2, voffA);
            PG8_BAR; PG8_WAIT_L(0); PG8_MMA(1, 0, At, B0); PG8_BAR; PG8_SCHED;
            PG8_STAGE(PG8_SB(0, 1), b2 + hstep, voffB);
            PG8_WAIT_V(6); PG8_BAR; PG8_MMA(1, 1, At, B1); PG8_BAR;
            PG8_LDB(B0, 1, 0); PG8_SCHED; PG8_LDA(At, 1, 0); PG8_STAGE(PG8_SA(0, 1), a2 + hstep, voffA);
            PG8_WAIT_L(8); PG8_BAR; PG8_WAIT_L(0); PG8_MMA(0, 0, At, B0); PG8_BAR; PG8_SCHED;
            PG8_LDB(B1, 1, 1); PG8_STAGE(PG8_SB(1, 0), b3, voffB);
            PG8_BAR; PG8_WAIT_L(0); PG8_MMA(0, 1, At, B1); PG8_BAR;
            PG8_LDA(At, 1, 1); PG8_STAGE(PG8_SA(1, 0), a3, voffA);
            PG8_BAR; PG8_WAIT_L(0); PG8_MMA(1, 0, At, B0); PG8_BAR; PG8_SCHED;
            PG8_STAGE(PG8_SB(1, 1), b3 + hstep, voffB);
            PG8_WAIT_V(6); PG8_BAR; PG8_MMA(1, 1, At, B1); PG8_BAR;
        }
        if constexpr (!Epi::AFTER_DRAIN) { E(acc, cur, wr, wc, fr, fq); S.done(cur); }
        if (!has_next) break;
#pragma unroll
        for (int a = 0; a < 2; ++a)
#pragma unroll
            for (int b = 0; b < 2; ++b)
#pragma unroll
                for (int m = 0; m < 4; ++m)
#pragma unroll
                    for (int n = 0; n < 2; ++n) acc[a][b][m][n] = (f32x4){0.f, 0.f, 0.f, 0.f};
        cur = nxt; cA = nA; cB = nB; ++ui;
    }
    PG8_WAIT_V(0);
    if (wr == 0) PG8_BAR;
    PG8_BAR;
    if constexpr (Epi::AFTER_DRAIN) { E.fused(acc, cur, wr, wc, fr, fq, lds, wid, lane); S.done(cur); }
#undef PG8_STAMP
#undef PG8_SA
#undef PG8_SB
#undef PG8_STAGE
#undef PG8_LDA
#undef PG8_LDB
#undef PG8_MMA
#undef PG8_WAIT_V
#undef PG8_WAIT_L
#undef PG8_BAR
#undef PG8_SCHED
}
}
#ifndef KILL_SKIPS_EPI
#define KILL_SKIPS_EPI 0
#endif
using pg8::Unit; using pg8::HALF; using pg8::BM;
struct EpiSwiglu {
  static constexpr bool PERM = true, AFTER_DRAIN = false;
  bf16_t* O; int wv; int skip = 0;
  DI void kill() { skip = 1; }
  DI void operator()(const f32x4 (&acc)[2][2][4][2], const Unit& u, int wr, int wc, int fr_, int fq_) const {
    const int ln_ = otid(wv) & 63, fr = ln_ & 15, fq = ln_ >> 4;
    if (skip) return;
    const int row0 = u.pm * BM + wr * 64 + fr, col0 = u.pn * 128 + wc * 32 + 8 * fq;
#pragma unroll
    for (int ai = 0; ai < 2; ++ai)
#pragma unroll
      for (int m = 0; m < 4; ++m) {
        const f32x4 g0 = acc[ai][0][m][0], g1 = acc[ai][0][m][1], u0 = acc[ai][1][m][0], u1 = acc[ai][1][m][1];
        u32x4 w;
        w.x = pk_bf16(silu_f(g0[0]) * u0[0], silu_f(g0[1]) * u0[1]); w.y = pk_bf16(silu_f(g0[2]) * u0[2], silu_f(g0[3]) * u0[3]);
        w.z = pk_bf16(silu_f(g1[0]) * u1[0], silu_f(g1[1]) * u1[1]); w.w = pk_bf16(silu_f(g1[2]) * u1[2], silu_f(g1[3]) * u1[3]);
        *(u32x4*)(O + (size_t)(row0 + ai * HALF + m * 16) * DFF + col0) = w;
      }
  }
};
struct EpiResid {
  static constexpr bool PERM = false, AFTER_DRAIN = false;
  bf16_t* xb; float* xc; float* part; const float* mod;
  float coef; int wv; int skip = 0; int ksub = 0;
  DI void kill() { coef = 0.f; skip = KILL_SKIPS_EPI; }
  DI void operator()(const f32x4 (&acc)[2][2][4][2], const Unit& u, int wr, int wc, int fr_, int fq_) const {
    const int ln_ = otid(wv) & 63, fr = ln_ & 15, fq = ln_ >> 4;
    const int row0 = u.pm * BM + wr * 64 + fr, col0 = u.pn * BM + wc * 32 + 4 * fq;
    if (skip) return;
    const int bi = (u.pm < 64) ? (u.pm >> 4) : 4;
    const float* gp = mod + (size_t)bi * 9216 + col0;
    f32x4 gv[2][2];
#pragma unroll
    for (int bj = 0; bj < 2; ++bj)
#pragma unroll
      for (int n = 0; n < 2; ++n) gv[bj][n] = *(const f32x4*)(gp + bj * HALF + n * 16) * coef;
#pragma unroll
    for (int ai = 0; ai < 2; ++ai) {
      f32x4 xv[4][2][2];
      const bool lat = u.pm < 64;
#pragma unroll
      for (int m = 0; m < 4; ++m) {
        const int r = row0 + ai * HALF + m * 16;
        if (!(ksub && u.pm >= 64)) {
#pragma unroll
          for (int bj = 0; bj < 2; ++bj)
#pragma unroll
            for (int n = 0; n < 2; ++n) {
              const int c = col0 + bj * HALF + n * 16;
              xv[m][bj][n] = lat ? bf4_to_f32(*(const u32x2*)(xb + (size_t)r * 1024 + c)) : *(const f32x4*)(xc + (size_t)(r - NLAT) * 1024 + c);
            }
        }
      }
#pragma unroll
      for (int m = 0; m < 4; ++m)
#pragma unroll
        for (int bj = 0; bj < 2; ++bj)
#pragma unroll
          for (int n = 0; n < 2; ++n) {
            const int r = row0 + ai * HALF + m * 16, c = col0 + bj * HALF + n * 16;
            const f32x4 d = gv[bj][n] * acc[ai][bj][m][n];
            if (ksub && u.pm >= 64) *(f32x4*)(part + ((size_t)(u.koff / ksub) * 1024 + (r - NLAT)) * 1024 + c) = d;
            else if (lat) *(u32x2*)(xb + (size_t)r * 1024 + c) = f32_to_bf4(xv[m][bj][n] + d);
            else *(f32x4*)(xc + (size_t)(r - NLAT) * 1024 + c) = xv[m][bj][n] + d;
          }
    }
  }
};
struct EpiProj {
  static constexpr bool PERM = true, AFTER_DRAIN = false;
  gchar* ws; int wv;
  DI void kill() {}
  DI void operator()(const f32x4 (&acc)[2][2][4][2], const Unit& u, int wr, int wc, int fr_, int fq_) const {
    const int ln_ = otid(wv) & 63, fr = ln_ & 15, fq = ln_ >> 4;
    const int row0 = u.pm * BM + wr * 64 + fr, col0 = u.pn * BM + wc * 32 + 8 * fq;
    if (u.pn >= 3) {
      bf16_t* O = (bf16_t*)(ws + OFF_PROJ);
#pragma unroll
      for (int ai = 0; ai < 2; ++ai)
#pragma unroll
        for (int m = 0; m < 4; ++m)
#pragma unroll
          for (int bj = 0; bj < 2; ++bj) {
            const f32x4 v0 = acc[ai][bj][m][0], v1 = acc[ai][bj][m][1];
            u32x4 w; w.x = pk_bf16(v0[0], v0[1]); w.y = pk_bf16(v0[2], v0[3]); w.z = pk_bf16(v1[0], v1[1]); w.w = pk_bf16(v1[2], v1[3]);
            *(u32x4*)(O + (size_t)(row0 + ai * HALF + m * 16) * NINP + col0 + bj * HALF) = w;
          }
    } else {
#pragma unroll
      for (int ai = 0; ai < 2; ++ai)
#pragma unroll
        for (int m = 0; m < 4; ++m) {
          const int r = row0 + ai * HALF + m * 16;
          bf16_t* base; int ld;
          if (r < NLAT) { base = (bf16_t*)(ws + OFF_PT) + (size_t)(r >> 12) * 768 * 4096 + (r & 4095); ld = 4096; }
          else { const int rc = r - NLAT; base = (bf16_t*)(ws + OFF_PTC) + (size_t)(rc >> 8) * 768 * 256 + (rc & 255); ld = 256; }
#pragma unroll
          for (int bj = 0; bj < 2; ++bj)
#pragma unroll
            for (int n = 0; n < 2; ++n)
#pragma unroll
              for (int j = 0; j < 4; ++j) base[(size_t)(col0 + bj * HALF + 4 * n + j) * ld] = f2bf(acc[ai][bj][m][n][j]);
        }
    }
  }
};
struct EpiQ {
  static constexpr bool PERM = false, AFTER_DRAIN = false;
  gchar* ws; int wv;
  DI void kill() {}
  DI void operator()(const f32x4 (&acc)[2][2][4][2], const Unit& u, int wr, int wc, int fr_, int fq_) const {
    const int ln_ = otid(wv) & 63, fr = ln_ & 15, fq = ln_ >> 4;
    const float qs = 0.10206207261596577f * 1.4426950408889634f;
    const int row0 = u.pm * BM + wr * 64 + fr, col0 = u.pn * BM + wc * 32 + 4 * fq;
    bf16_t* Q = (bf16_t*)(ws + OFF_Q);
    const int b = u.pm < 64 ? (u.pm >> 4) : u.pm - 64, p0 = u.pm < 64 ? 256 + ((u.pm & 15) << 8) : 0;
    const f32x2* rope = (const f32x2*)(ws + OFF_ROPE);
#pragma unroll
    for (int ai = 0; ai < 2; ++ai)
#pragma unroll
      for (int m = 0; m < 4; ++m) {
        const int r = row0 + ai * HALF + m * 16, p = p0 + wr * 64 + fr + ai * HALF + m * 16;
#pragma unroll
        for (int bj = 0; bj < 2; ++bj)
#pragma unroll
          for (int n = 0; n < 2; ++n) {
            const int c = col0 + bj * HALF + n * 16, h = c / 96, d = c - h * 96;
            f32x4 v = acc[ai][bj][m][n];
            if (d >= 64 && r < NLAT) {
              const int rp = d - 64, a = rp >> 4, q0 = (rp & 15) >> 1, npos = r & 4095, coord = a ? (npos & 63) : (npos >> 6);
              const f32x2 cs0 = rope[coord * 8 + q0], cs1 = rope[coord * 8 + q0 + 1];
              const f32x4 t = v;
              v[0] = t[0] * cs0.x - t[1] * cs0.y; v[1] = t[1] * cs0.x + t[0] * cs0.y;
              v[2] = t[2] * cs1.x - t[3] * cs1.y; v[3] = t[3] * cs1.x + t[2] * cs1.y;
            }
            u32x2 w; w.x = pk_bf16(v[0] * qs, v[1] * qs); w.y = pk_bf16(v[2] * qs, v[3] * qs);
            *(u32x2*)(Q + ((size_t)(b * 8 + h) * NPOS + p) * 96 + d) = w;
          }
      }
  }
};
struct EpiKV {
  static constexpr bool PERM = false, AFTER_DRAIN = false;
  gchar* ws; int wv;
  DI void kill() {}
  DI void operator()(const f32x4 (&acc)[2][2][4][2], const Unit& u, int wr, int wc, int fr_, int fq_) const {
    const int ln_ = otid(wv) & 63, fr = ln_ & 15, fq = ln_ >> 4;
    const int row0 = u.pm * BM + wr * 64 + fr, col0 = u.pn * BM + wc * 32 + 4 * fq;
    bf16_t* KN = (bf16_t*)(ws + OFF_KN); bf16_t* VT = (bf16_t*)(ws + OFF_VT);
    const int b = u.pm < 64 ? (u.pm >> 4) : u.pm - 64, p0 = u.pm < 64 ? 256 + ((u.pm & 15) << 8) : 0;
#pragma unroll
    for (int ai = 0; ai < 2; ++ai)
#pragma unroll
      for (int m = 0; m < 4; ++m) {
        const int r = row0 + ai * HALF + m * 16, p = p0 + wr * 64 + fr + ai * HALF + m * 16;
#pragma unroll
        for (int bj = 0; bj < 2; ++bj)
#pragma unroll
          for (int n = 0; n < 2; ++n) {
            const int c = col0 + bj * HALF + n * 16, h = c >> 7, d = c & 127;
            const f32x4 v = acc[ai][bj][m][n];
            if (d < 64) { u32x2 w; w.x = pk_bf16(v[0], v[1]); w.y = pk_bf16(v[2], v[3]); *(u32x2*)(KN + ((size_t)(b * 8 + h) * NPOS + p) * 64 + d) = w; }
            else {
#pragma unroll
              for (int j = 0; j < 4; ++j) VT[((size_t)(b * 8 + h) * 64 + (d - 64 + j)) * NPOS + p] = f2bf(v[j]);
            }
          }
      }
  }
};
constexpr int WJ_ND[8] = {5632, 5632, 1024, 1024, 2048, 1024, 768, 1024};
constexpr int WJ_K[8] = {1024, 1024, 2816, 2816, 1024, 1024, 384, 256};
constexpr int WJ_T0[9] = {0, 352, 704, 880, 1056, 1184, 1248, 1266, 1282};
DI size_t wj_off(int j) { return j == 0 ? WO_UP1 : j == 1 ? WO_UP2 : j == 2 ? WO_D1 : j == 3 ? WO_D2 : j == 4 ? WO_IN : j == 5 ? WO_OUT : j == 6 ? WO_UQ : WO_UKV; }
struct WtLoad { f32x4 v[8]; int l, job, r0, k0, K; };
DI WtLoad wt_load(const Params& P, int gt, int tid) {
  WtLoad o;
  const int l = gt / 1282, lt = gt - l * 1282;
  int job = 0;
#pragma unroll
  for (int j = 1; j < 8; ++j) if (lt >= WJ_T0[j]) job = j;
  const int t = lt - WJ_T0[job], K = WJ_K[job], kt = K >> 6, r0 = (t / kt) * 256, k0 = (t % kt) * 64;
  const int tr4 = tid & 63, tk = tid >> 6, r = r0 + 4 * tr4;
  const float* base; int Ns, col = r;
  if (job < 2) { const int tt = r >> 8, bj = (r >> 7) & 1, c = r & 127; col = 128 * tt + c; Ns = DFF;
    base = P.in[job == 0 ? (bj ? I_F1U : I_F1G) : (bj ? I_F2U : I_F2G)] + (size_t)l * 1024 * DFF; }
  else if (job < 4) { base = P.in[job == 2 ? I_F1D : I_F2D] + (size_t)l * DFF * 1024; Ns = 1024; }
  else if (job == 4) { base = P.in[I_WIN] + (size_t)l * 1024 * NIN; Ns = NIN; if (r >= NIN) col = -1; }
  else if (job == 5) { base = P.in[I_WOUT] + (size_t)l * 1024 * 1024; Ns = 1024; }
  else if (job == 6) { base = P.in[I_WUQ] + (size_t)l * 384 * 768; Ns = 768; }
  else { base = P.in[I_WUKV] + (size_t)l * 256 * 1024; Ns = 1024; }
  if (job == 6) {
#pragma unroll
    for (int kk = 0; kk < 8; ++kk)
#pragma unroll
      for (int j = 0; j < 4; ++j) {
        const int rr = r + j, h = rr / 96, d = rr - h * 96; int cc = rr;
        if (d >= 64) { const int rp = d - 64, a = rp >> 4, q = (rp & 15) >> 1, pp = rp & 1; cc = h * 96 + 64 + a * 16 + pp * 8 + q; }
        o.v[kk][j] = base[(size_t)(k0 + tk * 8 + kk) * Ns + cc];
      }
  } else {
#pragma unroll
    for (int kk = 0; kk < 8; ++kk) o.v[kk] = col >= 0 ? __builtin_nontemporal_load((const f32x4*)(base + (size_t)(k0 + tk * 8 + kk) * Ns + col)) : (f32x4){0.f, 0.f, 0.f, 0.f};
  }
  o.l = l; o.job = job; o.r0 = r0; o.k0 = k0; o.K = K;
  return o;
}
DI void wt_store(const Params& P, const WtLoad& o, unsigned char* lds, int tid) {
  const int tr4 = tid & 63, tk = tid >> 6;
  bf16_t* tile = (bf16_t*)lds;
#pragma unroll
  for (int j = 0; j < 4; ++j) {
    u32x4 w; w.x = pk_bf16(o.v[0][j], o.v[1][j]); w.y = pk_bf16(o.v[2][j], o.v[3][j]); w.z = pk_bf16(o.v[4][j], o.v[5][j]); w.w = pk_bf16(o.v[6][j], o.v[7][j]);
    *(u32x4*)(tile + (4 * tr4 + j) * 72 + tk * 8) = w;
  }
  __syncthreads();
  bf16_t* dst = (bf16_t*)(ows(P) + OFF_W) + (size_t)o.l * WL_ELEMS + wj_off(o.job);
#pragma unroll
  for (int i = 0; i < 4; ++i) { const int idx = tid + 512 * i, rr = idx >> 3, ch = idx & 7;
    *(u32x4*)(dst + (size_t)(o.r0 + rr) * o.K + o.k0 + ch * 8) = *(const u32x4*)(tile + rr * 72 + ch * 8); }
  __syncthreads();
}
DI void ada_tile(const Params& P, int t, unsigned char* lds, int wv) {
  const int tid = otid(wv), l = t / 72, j0 = (t % 72) * 128, jl = tid & 31, ks = tid >> 5;
  const float* W = P.in[I_ADAW] + (size_t)l * 1024 * 9216 + j0 + 4 * jl;
  f32x4 acc[5];
#pragma unroll
  for (int bi = 0; bi < 5; ++bi) acc[bi] = (f32x4){0.f, 0.f, 0.f, 0.f};
#pragma unroll 8
  for (int k = ks * 64; k < ks * 64 + 64; ++k) {
    const f32x4 w4 = __builtin_nontemporal_load((const f32x4*)(W + (size_t)k * 9216));
#pragma unroll
    for (int bi = 0; bi < 5; ++bi) { const float cv = bi < 4 ? P.in[I_C][bi * 1024 + k] : P.in[I_CCTX][k]; acc[bi] += w4 * silu_f(cv); }
  }
  float* red = (float*)lds;
#pragma unroll
  for (int bi = 0; bi < 5; ++bi) *(f32x4*)(red + (ks * 5 + bi) * 128 + 4 * jl) = acc[bi];
  __syncthreads();
  for (int o = tid; o < 640; o += 512) {
    const int bi = o >> 7, j = o & 127; float s = 0.f;
#pragma unroll
    for (int k2 = 0; k2 < 16; ++k2) s += red[(k2 * 5 + bi) * 128 + j];
    ((float*)(ows(P) + OFF_MOD))[(size_t)(l * 5 + bi) * 9216 + j0 + j] = s + P.in[I_ADAB][l * 9216 + j0 + j];
  }
  __syncthreads();
}
DI void h2_pos(const Params& P, int idx, int wv) {
  const int lane = otid(wv) & 63;
  const int l = idx / 4352, rem = idx - l * 4352;
  const bool lat = rem < 4096; const int pos = lat ? rem : rem - 4096; const float L = lat ? 4096.f : 256.f;
  const float tn = (float)pos / (L - 1.f), w = 6.2831855f * (float)pos / L;
  float z = 0.f;
  if (lane == 0) z = tn;
  else if (lane < 33) { const int i = (lane - 1) & 15; const float band = 1e-4f + (float)i * ((15.f - 1e-4f) / 15.f), ang = w * band; z = lane < 17 ? cosf(ang) : -sinf(ang); }
  const float* w1 = P.in[I_HW1] + (size_t)l * 33 * 64; const float* w2 = P.in[I_HW2] + (size_t)l * 64 * 64;
  float h1 = P.in[I_HB1][l * 64 + lane];
#pragma unroll
  for (int i = 0; i < 33; ++i) h1 += rdlane(z, i) * w1[i * 64 + lane];
  h1 = sinf(P.in[I_HFREQ][l * 128 + lane] * h1);
  float h2 = P.in[I_HB2][l * 64 + lane];
#pragma unroll
  for (int m = 0; m < 64; ++m) h2 += rdlane(h1, m) * w2[m * 64 + lane];
  h2 = sinf(P.in[I_HFREQ][l * 128 + 64 + lane] * h2);
  float* dst = lat ? (float*)(ows(P) + OFF_H2) + ((size_t)l * 4096 + pos) * 64 : (float*)(ows(P) + OFF_H2C) + ((size_t)l * 256 + pos) * 64;
  dst[lane] = h2;
}
DI void phase0(const Params& P, unsigned char* lds, int wv) {
  const int tid = otid(wv), wave = tid >> 6, nb = gridDim.x, bid = blockIdx.x;
  for (int i = bid * 512 + tid; i < 4096 + 512 + 2 * 65536; i += nb * 512) {
    if (i < 4096) { float s, c; sincospif(-(float)i * (1.f / 4096.f), &s, &c); ((f32x2*)(ows(P) + OFF_TW))[i] = (f32x2){c, s}; }
    else if (i < 4608) { const int k = i - 4096, coord = k >> 3, q = k & 7; const float inv = 1.0f / powf(10000.f, (float)q / 8.f), ang = (float)coord * inv;
      ((f32x2*)(ows(P) + OFF_ROPE))[k] = (f32x2){cosf(ang), sinf(ang)}; }
    else { const int k = i - 4608, l = k >> 16, e = k & 65535; ((bf16_t*)(ows(P) + OFF_W))[(size_t)l * WL_ELEMS + WO_S + e] = f2bf(P.in[I_SGW][k]); }
  }
  for (int t = bid; t < 144; t += nb) ada_tile(P, t, lds, wv);
  for (int i = bid * 8 + wave; i < 8704; i += nb * 8) h2_pos(P, i, wv);
  {
    int t = bid; WtLoad cur; if (t < 2 * 1282) cur = wt_load(P, t, tid);
    while (t < 2 * 1282) { const int tn = t + nb; WtLoad nxt; if (tn < 2 * 1282) nxt = wt_load(P, tn, tid); wt_store(P, cur, lds, tid); cur = nxt; t = tn; }
  }
}
template <bool FIRST> DI void prep_phase(const Params& P, int l, int sidx, int wv, int nrows = MTOT, int nsplit = 0) {
  const int tid = otid(wv), wave = tid >> 6, lane = tid & 63;
  const float* mod = (const float*)(ows(P) + OFF_MOD) + (size_t)l * 5 * 9216;
  bf16_t* H = (bf16_t*)(ows(P) + OFF_H);
  const int stride = gridDim.x * 8;
  int r = blockIdx.x * 8 + wave;
  f32x4 v[4];
  if (r < nrows) {
    if (FIRST) { const float* src = r < NLAT ? P.in[I_X] + (size_t)r * 1024 : P.in[I_CTX] + (size_t)(r - NLAT) * 1024;
#pragma unroll
      for (int i = 0; i < 4; ++i) v[i] = __builtin_nontemporal_load((const f32x4*)(src + i * 256 + lane * 4)); }
    else {
#pragma unroll
      for (int i = 0; i < 4; ++i) v[i] = xload(P, r, i * 256 + lane * 4); }
  }
  f32x4 scc[4], shc[4]; int bic = -1;
  while (r < nrows) {
    const int rn = r + stride; f32x4 vn[4];
    if (rn < nrows) {
      if (FIRST) { const float* src = rn < NLAT ? P.in[I_X] + (size_t)rn * 1024 : P.in[I_CTX] + (size_t)(rn - NLAT) * 1024;
#pragma unroll
        for (int i = 0; i < 4; ++i) vn[i] = __builtin_nontemporal_load((const f32x4*)(src + i * 256 + lane * 4)); }
      else {
#pragma unroll
        for (int i = 0; i < 4; ++i) vn[i] = xload(P, rn, i * 256 + lane * 4); }
    }
    const int bi = r < NLAT ? (r >> 12) : 4;
    if (bi != bic) { const float* sh = mod + (size_t)bi * 9216 + sidx * 1024; const float* sc = sh + 1024; bic = bi;
#pragma unroll
      for (int i = 0; i < 4; ++i) { scc[i] = *(const f32x4*)(sc + i * 256 + lane * 4) + 1.f; shc[i] = *(const f32x4*)(sh + i * 256 + lane * 4); } }
    if (!FIRST && nsplit > 0 && r >= NLAT) {
      const float* pp = (const float*)(ows(P) + OFF_PART) + (size_t)(r - NLAT) * 1024;
      for (int s = 0; s < nsplit; ++s)
#pragma unroll
        for (int i = 0; i < 4; ++i) v[i] += *(const f32x4*)(pp + (size_t)s * 1024 * 1024 + i * 256 + lane * 4);
#pragma unroll
      for (int i = 0; i < 4; ++i) xstore(P, r, i * 256 + lane * 4, v[i]);
    }
    float ss = 0.f;
#pragma unroll
    for (int i = 0; i < 4; ++i) ss += v[i][0] * v[i][0] + v[i][1] * v[i][1] + v[i][2] * v[i][2] + v[i][3] * v[i][3];
    ss = wave_sum(ss, lane);
    const float rs = rsqrtf(ss * (1.f / 1024.f) + 1e-6f);
#pragma unroll
    for (int i = 0; i < 4; ++i) {
      const int c = i * 256 + lane * 4;
      if (FIRST) xstore(P, r, c, v[i]);
      const f32x4 o = v[i] * rs * scc[i] + shc[i];
      u32x2 w; w.x = pk_bf16(o[0], o[1]); w.y = pk_bf16(o[2], o[3]);
      *(u32x2*)(H + (size_t)r * 1024 + c) = w;
    }
#pragma unroll
    for (int i = 0; i < 4; ++i) v[i] = vn[i];
    r = rn;
  }
}
DI void final_phase(const Params& P, int wv) {
  const int tid = otid(wv), wave = tid >> 6, lane = tid & 63;
  const float* fn = P.in[I_FN];
  f32x4 fng[4];
#pragma unroll
  for (int i = 0; i < 4; ++i) fng[i] = *(const f32x4*)(fn + i * 256 + lane * 4);
  const int stride = gridDim.x * 8;
  int r = blockIdx.x * 8 + wave;
  f32x4 v[4];
  if (r < NLAT) {
#pragma unroll
    for (int i = 0; i < 4; ++i) v[i] = xload(P, r, i * 256 + lane * 4); }
  while (r < NLAT) {
    const int rn = r + stride; f32x4 vn[4];
    if (rn < NLAT) {
#pragma unroll
      for (int i = 0; i < 4; ++i) vn[i] = xload(P, rn, i * 256 + lane * 4); }
    float* X = P.out + (size_t)r * 1024;
    float ss = 0.f;
#pragma unroll
    for (int i = 0; i < 4; ++i) ss += v[i][0] * v[i][0] + v[i][1] * v[i][1] + v[i][2] * v[i][2] + v[i][3] * v[i][3];
    ss = wave_sum(ss, lane);
    const float rs = rsqrtf(ss * (1.f / 1024.f) + 1e-6f);
#pragma unroll
    for (int i = 0; i < 4; ++i) __builtin_nontemporal_store(v[i] * rs * fng[i], (f32x4*)(X + i * 256 + lane * 4));
#pragma unroll
    for (int i = 0; i < 4; ++i) v[i] = vn[i];
    r = rn;
  }
}
typedef float cpx __attribute__((ext_vector_type(2)));
#define FD DI
#define CPX_VEC 1
FD int sw(int i) { return i ^ (((i >> 5) & 7) | (((i >> 6) & 3) << 3)); }
#ifdef CPX_VEC
FD cpx cmul(cpx a, cpx b) { return a.xx * b + a.yy * cpx{-b.y, b.x}; }
FD cpx cmulc(cpx a, cpx b) { return a.xx * cpx{b.x, -b.y} + a.yy * b.yx; }
FD cpx cadd(cpx a, cpx b) { return a + b; }
FD cpx csub(cpx a, cpx b) { return a - b; }
#else
FD cpx cmul(cpx a, cpx b) { return cpx{a.x * b.x - a.y * b.y, a.x * b.y + a.y * b.x}; }
FD cpx cmulc(cpx a, cpx b) { return cpx{a.x * b.x + a.y * b.y, a.y * b.x - a.x * b.y}; }
FD cpx cadd(cpx a, cpx b) { return cpx{a.x + b.x, a.y + b.y}; }
FD cpx csub(cpx a, cpx b) { return cpx{a.x - b.x, a.y - b.y}; }
#endif
#ifdef CPX_VEC
#define C8_H(h) const float h = 0.70710678118654752f
#else
#define C8_H(h) const float h = 0.70710678118654752f
#endif
FD cpx cmul_c8(cpx a, int q) {
  if (q == 0) return a;
  if (q == 2) return cpx{a.y, -a.x};
  C8_H(h);
  if (q == 1) return cpx{(a.x + a.y) * h, (a.y - a.x) * h};
  return cpx{(a.y - a.x) * h, -(a.x + a.y) * h};
}
FD void bfly8_dif(cpx (&x)[8], cpx w1) {
  const cpx w2 = cmul(w1, w1), w4 = cmul(w2, w2);
#pragma unroll
  for (int q = 0; q < 4; ++q) { cpx a = x[q], b = x[q + 4]; x[q] = cadd(a, b); x[q + 4] = cmul(cmul_c8(csub(a, b), q), w1); }
#pragma unroll
  for (int hf = 0; hf < 8; hf += 4)
#pragma unroll
    for (int q = 0; q < 2; ++q) { cpx a = x[hf + q], b = x[hf + q + 2]; x[hf + q] = cadd(a, b); x[hf + q + 2] = cmul(cmul_c8(csub(a, b), 2 * q), w2); }
#pragma unroll
  for (int q = 0; q < 8; q += 2) { cpx a = x[q], b = x[q + 1]; x[q] = cadd(a, b); x[q + 1] = cmul(csub(a, b), w4); }
}
template <int HALF = 0, class PT, class PTW> FD void fft_r8_dif(PT W, int lg, PTW TW, int tid) {
  const int len = 1 << lg, e = len >> 3, ts = (8192 >> lg) >> HALF;
  for (int gid = tid; gid < 1024; gid += 512) {
    const int blk = gid >> (lg - 3), j = gid & (e - 1), base = (blk << lg) + j;
    cpx x[8];
#pragma unroll
    for (int q = 0; q < 8; ++q) x[q] = W[sw(base + q * e)];
    bfly8_dif(x, TW[j * ts]);
#pragma unroll
    for (int q = 0; q < 8; ++q) W[sw(base + q * e)] = x[q];
  }
}
FD cpx cmulc_c8(cpx a, int q) {
  if (q == 0) return a;
  if (q == 2) return cpx{-a.y, a.x};
  C8_H(h);
  if (q == 1) return cpx{(a.x - a.y) * h, (a.x + a.y) * h};
  return cpx{-(a.x + a.y) * h, (a.x - a.y) * h};
}
FD void bfly8_dit(cpx (&x)[8], cpx w1) {
  const cpx w2 = cmul(w1, w1), w4 = cmul(w2, w2);
#pragma unroll
  for (int q = 0; q < 8; q += 2) { cpx a = x[q], b = cmulc(x[q + 1], w4); x[q] = cadd(a, b); x[q + 1] = csub(a, b); }
#pragma unroll
  for (int hf = 0; hf < 8; hf += 4)
#pragma unroll
    for (int q = 0; q < 2; ++q) { cpx a = x[hf + q], b = cmulc_c8(cmulc(x[hf + q + 2], w2), 2 * q); x[hf + q] = cadd(a, b); x[hf + q + 2] = csub(a, b); }
#pragma unroll
  for (int q = 0; q < 4; ++q) { cpx a = x[q], b = cmulc_c8(cmulc(x[q + 4], w1), q); x[q] = cadd(a, b); x[q + 4] = csub(a, b); }
}
template <int HALF = 0, class PT, class PTW> FD void ifft_r8_dit(PT W, int lg, PTW TW, int tid) {
  const int len = 1 << lg, e = len >> 3, ts = (8192 >> lg) >> HALF;
  for (int gid = tid; gid < 1024; gid += 512) {
    const int blk = gid >> (lg - 3), j = gid & (e - 1), base = (blk << lg) + j;
    cpx x[8];
#pragma unroll
    for (int q = 0; q < 8; ++q) x[q] = W[sw(base + q * e)];
    bfly8_dit(x, TW[j * ts]);
#pragma unroll
    for (int q = 0; q < 8; ++q) W[sw(base + q * e)] = x[q];
  }
}
template <class PT> FD void fft_r2_first(PT W, const cpx* TW, int tid) {
  for (int i = tid; i < 4096; i += 512) { cpx a = W[sw(i)], b = W[sw(i + 4096)]; W[sw(i)] = cadd(a, b); W[sw(i + 4096)] = cmul(csub(a, b), TW[i]); }
}
FD int brev13(int x) {
  unsigned v = (unsigned)x; v = ((v >> 1) & 0x55555555u) | ((v & 0x55555555u) << 1); v = ((v >> 2) & 0x33333333u) | ((v & 0x33333333u) << 2);
  v = ((v >> 4) & 0x0F0F0F0Fu) | ((v & 0x0F0F0F0Fu) << 4); v = ((v >> 8) & 0x00FF00FFu) | ((v & 0x00FF00FFu) << 8); v = (v >> 16) | (v << 16); return (int)(v >> 19);
}
template <class PT, class PF> FD void spec_mul(PT W, PF F, int o, int tid) {
  for (int pos = tid; pos < 8192; pos += 512) {
    const int k = brev13(pos), kn = (8192 - k) & 8191, posn = brev13(kn);
    const cpx Z = F[sw(pos)], Zn = F[sw(posn)];
    cpx kf;
    if (o == 0) kf = cpx{0.5f * (Z.x + Zn.x), 0.5f * (Z.y - Zn.y)};
    else        kf = cpx{0.5f * (Z.y + Zn.y), -0.5f * (Z.x - Zn.x)};
    W[sw(pos)] = cmul(W[sw(pos)], kf);
  }
}
#define MFMA32(a, b, c) __builtin_amdgcn_mfma_f32_32x32x16_bf16((a), (b), (c), 0, 0, 0)
struct MixC { float qn[6], kvn[4]; f32x4 g4, b4; };
DI MixC mixprep_consts(const Params& P, int l, int wv) {
  const int lane = otid(wv) & 63; MixC c;
#pragma unroll
  for (int i = 0; i < 6; ++i) c.qn[i] = P.in[I_QN][l * 384 + lane + 64 * i];
#pragma unroll
  for (int i = 0; i < 4; ++i) c.kvn[i] = P.in[I_KVN][l * 256 + lane + 64 * i];
  c.g4 = *(const f32x4*)(P.in[I_SGG] + l * 256 + 4 * lane); c.b4 = *(const f32x4*)(P.in[I_SGB] + l * 256 + 4 * lane);
  return c;
}
DI void mixprep_row(const Params& P, int l, int r, int wv, const MixC& C) {
  const int lane = otid(wv) & 63;
  const bf16_t* pr = (const bf16_t*)(ows(P) + OFF_PROJ) + (size_t)r * NINP;
  float q[6], k[4];
#pragma unroll
  for (int i = 0; i < 6; ++i) q[i] = bf2f(pr[1280 + lane + 64 * i]);
#pragma unroll
  for (int i = 0; i < 4; ++i) k[i] = bf2f(pr[1664 + lane + 64 * i]);
  const u32x2 ru = *(const u32x2*)(pr + 768 + 4 * lane), rv2 = *(const u32x2*)(pr + 1024 + 4 * lane);
  const int a = (lane >> 4) & 1, qq = (lane & 15) >> 1, pp = lane & 1;
  const float xs = bf2f(pr[1920 + a * 16 + pp * 8 + qq]), xp = bf2f(pr[1920 + a * 16 + (1 - pp) * 8 + qq]);
  f32x2 cs = {1.f, 0.f};
  if (r < NLAT) { const int npos = r & 4095, coord = a ? (npos & 63) : (npos >> 6); cs = ((const f32x2*)(ows(P) + OFF_ROPE))[coord * 8 + qq]; }
  float ss = 0.f;
#pragma unroll
  for (int i = 0; i < 6; ++i) ss += q[i] * q[i];
  ss = wave_sum(ss, lane);
  float rs = rsqrtf(ss * (1.f / 384.f) + 1e-6f);
  bf16_t* cq = (bf16_t*)(ows(P) + OFF_CQN) + (size_t)r * 384;
#pragma unroll
  for (int i = 0; i < 6; ++i) cq[lane + 64 * i] = f2bf(q[i] * rs * C.qn[i]);
  ss = 0.f;
#pragma unroll
  for (int i = 0; i < 4; ++i) ss += k[i] * k[i];
  ss = wave_sum(ss, lane);
  rs = rsqrtf(ss * (1.f / 256.f) + 1e-6f);
  bf16_t* ck = (bf16_t*)(ows(P) + OFF_CKVN) + (size_t)r * 256;
#pragma unroll
  for (int i = 0; i < 4; ++i) ck[lane + 64 * i] = f2bf(k[i] * rs * C.kvn[i]);
  {
    const float u0 = gelu_f(__uint_as_float(ru.x << 16)), u1 = gelu_f(__uint_as_float(ru.x & 0xffff0000u)), u2 = gelu_f(__uint_as_float(ru.y << 16)), u3 = gelu_f(__uint_as_float(ru.y & 0xffff0000u));
    float v[4] = {gelu_f(__uint_as_float(rv2.x << 16)), gelu_f(__uint_as_float(rv2.x & 0xffff0000u)), gelu_f(__uint_as_float(rv2.y << 16)), gelu_f(__uint_as_float(rv2.y & 0xffff0000u))};
    const float mu = wave_sum(v[0] + v[1] + v[2] + v[3], lane) * (1.f / 256.f);
    float d2 = 0.f;
#pragma unroll
    for (int j = 0; j < 4; ++j) { v[j] -= mu; d2 += v[j] * v[j]; }
    const float rs2 = rsqrtf(wave_sum(d2, lane) * (1.f / 256.f) + 1e-6f);
    u32x2 wu, wv2; wu.x = pk_bf16(u0, u1); wu.y = pk_bf16(u2, u3);
    wv2.x = pk_bf16(v[0] * rs2 * C.g4[0] + C.b4[0], v[1] * rs2 * C.g4[1] + C.b4[1]); wv2.y = pk_bf16(v[2] * rs2 * C.g4[2] + C.b4[2], v[3] * rs2 * C.g4[3] + C.b4[3]);
    *(u32x2*)((bf16_t*)(ows(P) + OFF_UG) + (size_t)r * 256 + 4 * lane) = wu;
    *(u32x2*)((bf16_t*)(ows(P) + OFF_VN) + (size_t)r * 256 + 4 * lane) = wv2;
  }
  if (lane < 32) {
    const float o = r < NLAT ? (pp ? xs * cs.x + xp * cs.y : xs * cs.x - xp * cs.y) : xs;
    int b, p; row_bp(r, b, p);
    ((bf16_t*)(ows(P) + OFF_KR))[((size_t)b * NPOS + p) * 32 + lane] = f2bf(o);
  }
}
DI void sgu_item(const Params& P, int l, int item, unsigned char* lds, int wv) {
  const int tid = otid(wv), wave = tid >> 6, lane = tid & 63, ci = item >> 1, gp = item & 1, r0 = ci * 128;
  const bf16_t* VN = (const bf16_t*)(ows(P) + OFF_VN); const bf16_t* UG = (const bf16_t*)(ows(P) + OFF_UG);
  bf16_t* vT = (bf16_t*)lds;
#pragma unroll
  for (int i = 0; i < 4; ++i) {
    const int e = tid + 512 * i, q = e >> 4, c8 = (e & 15) * 8;
    const u32x4 raw = *(const u32x4*)(VN + (size_t)(r0 + q) * 256 + gp * 128 + c8);
    const unsigned w[4] = {raw.x, raw.y, raw.z, raw.w};
#pragma unroll
    for (int j = 0; j < 4; ++j) { vT[(c8 + 2 * j) * 136 + q] = (bf16_t)(w[j] & 0xffffu); vT[(c8 + 2 * j + 1) * 136 + q] = (bf16_t)(w[j] >> 16); }
  }
  __syncthreads();
  const int ql = lane & 31, hh = lane >> 5, gl = wave >> 2, g = 2 * gp + gl, chl = gl * 64 + (wave & 1) * 32 + ql, pt0 = ((wave >> 1) & 1) * 2;
  const bf16_t* Ws = (const bf16_t*)(ows(P) + OFF_W) + (size_t)l * WL_ELEMS + WO_S + (size_t)g * 128 * 128;
  f32x16 acc[2];
#pragma unroll
  for (int pt = 0; pt < 2; ++pt)
#pragma unroll
    for (int i = 0; i < 16; ++i) acc[pt][i] = 0.f;
#pragma unroll
  for (int s = 0; s < 8; ++s) {
    const bf16x8 bfr = *(const bf16x8*)(vT + chl * 136 + 16 * s + 8 * hh);
#pragma unroll
    for (int pt = 0; pt < 2; ++pt) {
      const bf16x8 afr = *(const bf16x8*)(Ws + (size_t)(32 * (pt0 + pt) + ql) * 128 + 16 * s + 8 * hh);
      acc[pt] = MFMA32(afr, bfr, acc[pt]);
    }
  }
  bf16_t* YC = (bf16_t*)(ows(P) + OFF_H);
  const float* bs = P.in[I_SGBS] + (size_t)l * 512 + g * 128;
  const int chg = gp * 128 + chl;
#pragma unroll
  for (int pt = 0; pt < 2; ++pt)
#pragma unroll
    for (int i = 0; i < 16; ++i) {
      const int p = 32 * (pt0 + pt) + (i & 3) + 8 * (i >> 2) + 4 * hh;
      const float u = bf2f(UG[(size_t)(r0 + p) * 256 + chg]);
      YC[(size_t)(r0 + p) * 1024 + 256 + chg] = f2bf(u * (acc[pt][i] + bs[p]));
    }
  __syncthreads();
}
DI float sconv(const bf16_t* p, int t, int L, float w0, float w1, float w2, float bb) {
  const float a = t > 0 ? bf2f(p[t - 1]) : 0.f, b = bf2f(p[t]), c = t < L - 1 ? bf2f(p[t + 1]) : 0.f;
  return w0 * a + w1 * b + w2 * c + bb;
}
DI void hyena_item(const Params& P, int l, int c, LAS unsigned char* lds, int wv) {
  const int tid = otid(wv);
  LAS cpx* W = (LAS cpx*)lds; LAS cpx* F = W + 8192; LAS float* w3s = (LAS float*)(F + 8192);
  LAS cpx* TW2 = (LAS cpx*)(lds + LDS_TW2_OFF);
  asm volatile("" : "+v"(F), "+v"(w3s), "+v"(TW2));
  const cpx* TW = (const cpx*)(ows(P) + OFF_TW);
#pragma unroll
  for (int i = 0; i < 4; ++i) TW2[tid + 512 * i] = TW[2 * (tid + 512 * i)];
  if (tid < 256) w3s[tid] = P.in[I_HW3][(size_t)l * 64 * 1024 + (tid & 63) * 1024 + (tid >> 6) * 256 + c];
  const float delta = 3.0701134573f + (float)c * ((15.350567286f - 3.0701134573f) / 255.f);
  const float* cwp = P.in[I_HCW] + (size_t)l * 3 * 768; const float* cbp = P.in[I_HCB] + (size_t)l * 768;
  float cw[3][3], cb[3];
#pragma unroll
  for (int k = 0; k < 3; ++k) { cb[k] = cbp[k * 256 + c];
#pragma unroll
    for (int j = 0; j < 3; ++j) cw[k][j] = cwp[j * 768 + k * 256 + c]; }
  const float bias0 = P.in[I_HBIAS][l * 512 + c], bias1 = P.in[I_HBIAS][l * 512 + 256 + c];
  bf16_t* YC = (bf16_t*)(ows(P) + OFF_H);
  __syncthreads();
#ifndef HYP_A
#define HYP_A 1
#endif
#ifndef HYP_B
#define HYP_B 1
#endif
#ifndef HYP_C
#define HYP_C 1
#endif
  for (int repa = 0; repa < HYP_A; ++repa)
  if (l == 0) {
    LAS float* kc = (LAS float*)W; LAS float* vb = kc + 1024; LAS float* v1b = vb + 1024;
    const float* H2C = (const float*)(ows(P) + OFF_H2C) + (size_t)l * 256 * 64;
    if (tid < 256) {
      const int t = tid; float d[4] = {0.f, 0.f, 0.f, 0.f};
      f32x4 hrow[16];
#pragma unroll
      for (int m4 = 0; m4 < 16; ++m4) hrow[m4] = *(const f32x4*)(H2C + t * 64 + 4 * m4);
#pragma unroll
      for (int m4 = 0; m4 < 16; ++m4)
#pragma unroll
        for (int od = 0; od < 4; ++od) { const f32x4 w = *(LAS const f32x4*)(w3s + od * 64 + 4 * m4); d[od] += hrow[m4][0] * w[0] + hrow[m4][1] * w[1] + hrow[m4][2] * w[2] + hrow[m4][3] * w[3]; }
      const float win = __expf(-((float)t / 255.f) * delta) + 0.05f;
      if (t == 0) { kc[255] = (d[0] + d[1]) * win; kc[512 + 255] = (d[2] + d[3]) * win; }
      else { kc[255 + t] = d[0] * win; kc[255 - t] = d[1] * win; kc[512 + 255 + t] = d[2] * win; kc[512 + 255 - t] = d[3] * win; }
    }
    const int cb_ = (tid >> 6) & 3, t0 = (tid & 63) * 4;
    const bf16_t* pbc = (const bf16_t*)(ows(P) + OFF_PTC) + (size_t)cb_ * 768 * 256;
    float x1r[4], x2r[4], vr[4], v1r[4];
    if (tid < 256) {
#pragma unroll
      for (int i = 0; i < 4; ++i) {
        x1r[i] = sconv(pbc + (size_t)c * 256, t0 + i, 256, cw[0][0], cw[0][1], cw[0][2], cb[0]);
        x2r[i] = sconv(pbc + (size_t)(256 + c) * 256, t0 + i, 256, cw[1][0], cw[1][1], cw[1][2], cb[1]);
        vr[i] = sconv(pbc + (size_t)(512 + c) * 256, t0 + i, 256, cw[2][0], cw[2][1], cw[2][2], cb[2]);
        vb[cb_ * 256 + t0 + i] = vr[i];
      }
    }
    __syncthreads();
#pragma unroll
    for (int o = 0; o < 2; ++o) {
      if (tid < 256) {
        LAS const float* src = o ? v1b : vb; LAS const float* kk = kc + o * 512 + 255 + t0;
        float y[4] = {0.f, 0.f, 0.f, 0.f};
        for (int s4 = 0; s4 < 64; ++s4) {
          const f32x4 u4 = *(LAS const f32x4*)(src + cb_ * 256 + 4 * s4);
          float kv[7];
#pragma unroll
          for (int j = 0; j < 7; ++j) kv[j] = kk[j - 3 - 4 * s4];
#pragma unroll
          for (int i = 0; i < 4; ++i)
#pragma unroll
            for (int j = 0; j < 4; ++j) y[i] += kv[3 + i - j] * u4[j];
        }
        if (o == 0) {
#pragma unroll
          for (int i = 0; i < 4; ++i) { v1r[i] = x1r[i] * (y[i] + vr[i] * bias0); v1b[cb_ * 256 + t0 + i] = v1r[i]; }
        } else {
#pragma unroll
          for (int i = 0; i < 4; ++i) YC[(size_t)(NLAT + cb_ * 256 + t0 + i) * 1024 + c] = f2bf(x2r[i] * (y[i] + v1r[i] * bias1));
        }
      }
      __syncthreads();
    }
  }
  for (int repb = 0; repb < HYP_B; ++repb)
  {
    const float* H2 = (const float*)(ows(P) + OFF_H2) + (size_t)l * 4096 * 64;
    LAS float* tile = (LAS float*)W; LAS float* Ff = (LAS float*)F;
    const int tl = tid & 127, od = tid >> 7;
    if (tid < 2) { float z0 = 0.f; asm volatile("" : "+v"(z0)); F[sw(tid * 4096)] = cpx{z0, z0}; }
    f32x4 w4[16];
#pragma unroll
    for (int m4 = 0; m4 < 16; ++m4) w4[m4] = *(LAS const f32x4*)(w3s + od * 64 + 4 * m4);
    f32x4 stg[4];
#pragma unroll
    for (int i = 0; i < 4; ++i) { const int e = tid + 512 * i; stg[i] = *(const f32x4*)(H2 + (size_t)(e >> 4) * 64 + 4 * (e & 15)); }
#pragma unroll 1
    for (int t0 = 0; t0 < 4096; t0 += 128) {
#pragma unroll
      for (int i = 0; i < 4; ++i) { const int e = tid + 512 * i, row = e >> 4, c4 = e & 15; *(LAS f32x4*)(tile + row * 68 + 4 * c4) = stg[i]; }
      if (t0 + 128 < 4096) {
#pragma unroll
        for (int i = 0; i < 4; ++i) { const int e = tid + 512 * i; stg[i] = *(const f32x4*)(H2 + (size_t)(t0 + 128 + (e >> 4)) * 64 + 4 * (e & 15)); }
      }
      __syncthreads();
      float d = 0.f;
#pragma unroll
      for (int m4 = 0; m4 < 16; ++m4) { const f32x4 hv = *(LAS const f32x4*)(tile + tl * 68 + 4 * m4); d += hv[0] * w4[m4][0] + hv[1] * w4[m4][1] + hv[2] * w4[m4][2] + hv[3] * w4[m4][3]; }
      const int t = t0 + tl;
      d *= __expf(-((float)t / 4095.f) * delta) + 0.05f;
      if (t == 0) atomicAdd((float*)(Ff + 2 * sw(0) + (od >> 1)), d);
      else Ff[2 * sw((od & 1) ? 8192 - t : t) + (od >> 1)] = d;
      __syncthreads();
    }
    __syncthreads();
    fft_r2_first(F, TW, tid); __syncthreads();
    fft_r8_dif<1>(F, 12, TW2, tid); __syncthreads(); fft_r8_dif<1>(F, 9, TW2, tid); __syncthreads(); fft_r8_dif<1>(F, 6, TW2, tid); __syncthreads(); fft_r8_dif<1>(F, 3, TW2, tid); __syncthreads();
  }
  for (int bp_ = 0; bp_ < 2 * HYP_C; ++bp_) { const int bp = bp_ & 1;
    float v[8][2];
    const bf16_t* pb0 = (const bf16_t*)(ows(P) + OFF_PT) + (size_t)(2 * bp) * 768 * 4096; const bf16_t* pb1 = pb0 + (size_t)768 * 4096;
#pragma unroll
    for (int i = 0; i < 8; ++i) {
      const int t = tid + 512 * i;
      v[i][0] = sconv(pb0 + (size_t)(512 + c) * 4096, t, 4096, cw[2][0], cw[2][1], cw[2][2], cb[2]);
      v[i][1] = sconv(pb1 + (size_t)(512 + c) * 4096, t, 4096, cw[2][0], cw[2][1], cw[2][2], cb[2]);
    }
#pragma unroll
    for (int o = 0; o < 2; ++o) {
      float gt[8][2];
#pragma unroll
      for (int i = 0; i < 8; ++i) {
        const int t = tid + 512 * i;
        gt[i][0] = sconv(pb0 + (size_t)(o * 256 + c) * 4096, t, 4096, cw[o][0], cw[o][1], cw[o][2], cb[o]);
        gt[i][1] = sconv(pb1 + (size_t)(o * 256 + c) * 4096, t, 4096, cw[o][0], cw[o][1], cw[o][2], cb[o]);
      }
      int t2 = tid; asm volatile("" : "+v"(t2));
      const cpx w12 = TW2[t2];
      {
        cpx lo[8];
#pragma unroll
        for (int q = 0; q < 8; ++q) lo[q] = cpx{v[q][0], v[q][1]};
        bfly8_dif(lo, w12);
#pragma unroll
        for (int q = 0; q < 8; ++q) W[sw(tid + 512 * q)] = lo[q];
        __builtin_amdgcn_sched_barrier(0);
#pragma unroll
        for (int q = 0; q < 8; ++q) lo[q] = cmul(cpx{v[q][0], v[q][1]}, TW[t2 + 512 * q]);
        bfly8_dif(lo, w12);
#pragma unroll
        for (int q = 0; q < 8; ++q) W[sw(4096 + tid + 512 * q)] = lo[q];
      }
      __syncthreads();
      fft_r8_dif<1>(W, 9, TW2, tid); __syncthreads(); fft_r8_dif<1>(W, 6, TW2, tid); __syncthreads(); fft_r8_dif<1>(W, 3, TW2, tid); __syncthreads();
      spec_mul(W, F, o, tid); __syncthreads();
      ifft_r8_dit<1>(W, 3, TW2, tid); __syncthreads(); ifft_r8_dit<1>(W, 6, TW2, tid); __syncthreads(); ifft_r8_dit<1>(W, 9, TW2, tid); __syncthreads();
      const float bo = o ? bias1 : bias0;
      cpx rlo[8], rup[8];
#pragma unroll
      for (int q = 0; q < 8; ++q) rlo[q] = W[sw(tid + 512 * q)];
      bfly8_dit(rlo, w12);
      __builtin_amdgcn_sched_barrier(0);
#pragma unroll
      for (int q = 0; q < 8; ++q) rup[q] = W[sw(4096 + tid + 512 * q)];
      bfly8_dit(rup, w12);
      int tq = tid; asm volatile("" : "+v"(tq));
#pragma unroll
      for (int i = 0; i < 8; ++i) {
        const int t = tid + 512 * i;
        cpx r = cadd(rlo[i], cmulc(rup[i], TW[tq + 512 * i])); r.x *= (1.f / 8192.f); r.y *= (1.f / 8192.f);
        const float g0 = gt[i][0], g1 = gt[i][1];
        if (o == 0) { v[i][0] = g0 * (r.x + v[i][0] * bo); v[i][1] = g1 * (r.y + v[i][1] * bo); }
        else {
          YC[(size_t)((2 * bp) * 4096 + t) * 1024 + c] = f2bf(g0 * (r.x + v[i][0] * bo));
          YC[(size_t)((2 * bp + 1) * 4096 + t) * 1024 + c] = f2bf(g1 * (r.y + v[i][1] * bo));
        }
      }
      __syncthreads();
#ifdef HYP_FFT
      for (int rp = 0; rp < HYP_FFT; ++rp) {
        fft_r8_dif<1>(W, 12, TW2, tid); __syncthreads(); fft_r8_dif<1>(W, 9, TW2, tid); __syncthreads(); fft_r8_dif<1>(W, 6, TW2, tid); __syncthreads(); fft_r8_dif<1>(W, 3, TW2, tid); __syncthreads();
        ifft_r8_dit<1>(W, 3, TW2, tid); __syncthreads(); ifft_r8_dit<1>(W, 6, TW2, tid); __syncthreads(); ifft_r8_dit<1>(W, 9, TW2, tid); __syncthreads(); ifft_r8_dit<1>(W, 12, TW2, tid); __syncthreads();
      }
#endif
    }
  }
}
constexpr int AT_KROW = 104, AT_VROW = 72, AT_STAGE = (64 * AT_KROW + 64 * AT_VROW) * 2;
DI void attn_item(const Params& P, int item, unsigned char* lds, int wv) {
  const int tid = otid(wv), wave = tid >> 6, lane = tid & 63, ql = lane & 31, hh = lane >> 5;
  const int qb = item % 17, bh = item / 17, b = bh >> 3, h = bh & 7;
  const int nt = qb == 0 ? 4 : 68;
  const int pq = qb * 256 + wave * 32 + ql;
  const bf16_t* qptr = (const bf16_t*)(ows(P) + OFF_Q) + ((size_t)bh * NPOS + pq) * 96 + 8 * hh;
  bf16x8 qf[6];
#pragma unroll
  for (int s = 0; s < 6; ++s) qf[s] = *(const bf16x8*)(qptr + 16 * s);
  const bf16_t* kn_src = (const bf16_t*)(ows(P) + OFF_KN) + ((size_t)bh * NPOS + (tid >> 3)) * 64 + (tid & 7) * 8;
  const bf16_t* kr_src = (const bf16_t*)(ows(P) + OFF_KR) + ((size_t)b * NPOS + ((tid & 255) >> 2)) * 32 + (tid & 3) * 8;
  const bf16_t* vt_src = (const bf16_t*)(ows(P) + OFF_VT) + ((size_t)bh * 64 + (tid >> 3)) * NPOS + (tid & 7) * 8;
  const int kn_dst = (tid >> 3) * AT_KROW + (tid & 7) * 8, kr_dst = ((tid & 255) >> 2) * AT_KROW + 64 + (tid & 3) * 8, vt_dst = 64 * AT_KROW + (tid >> 3) * AT_VROW + (tid & 7) * 8;
  u32x4 rk, rr = {0, 0, 0, 0}, rv;
  rk = *(const u32x4*)kn_src; if (tid < 256) rr = *(const u32x4*)kr_src; rv = *(const u32x4*)vt_src;
  { bf16_t* S0 = (bf16_t*)lds; *(u32x4*)(S0 + kn_dst) = rk; if (tid < 256) *(u32x4*)(S0 + kr_dst) = rr; *(u32x4*)(S0 + vt_dst) = rv; }
  __syncthreads();
  f32x16 o0, o1;
#pragma unroll
  for (int i = 0; i < 16; ++i) { o0[i] = 0.f; o1[i] = 0.f; }
  float mrun = -1e30f, lrun = 0.f;
  for (int t = 0; t < nt; ++t) {
    if (t + 1 < nt) { rk = *(const u32x4*)(kn_src + (size_t)(t + 1) * 64 * 64); if (tid < 256) rr = *(const u32x4*)(kr_src + (size_t)(t + 1) * 64 * 32); rv = *(const u32x4*)(vt_src + (t + 1) * 64); }
    const bf16_t* Kl = (const bf16_t*)(lds + (t & 1) * AT_STAGE); const bf16_t* Vl = Kl + 64 * AT_KROW;
    f32x16 s0, s1;
#pragma unroll
    for (int i = 0; i < 16; ++i) { s0[i] = 0.f; s1[i] = 0.f; }
    __builtin_amdgcn_s_setprio(1);
#pragma unroll
    for (int s = 0; s < 6; ++s) {
      const bf16x8 a0 = *(const bf16x8*)(Kl + ql * AT_KROW + 16 * s + 8 * hh), a1 = *(const bf16x8*)(Kl + (32 + ql) * AT_KROW + 16 * s + 8 * hh);
      s0 = MFMA32(a0, qf[s], s0); s1 = MFMA32(a1, qf[s], s1);
    }
    __builtin_amdgcn_s_setprio(0);
    float mx = s0[0];
#pragma unroll
    for (int i = 0; i < 16; ++i) mx = fmaxf(mx, fmaxf(s0[i], s1[i]));
    const float mxo = xshfl(mx, lane, 32);
    if (t == 0) mrun = fmaxf(mx, mxo);
    float ps = 0.f;
#pragma unroll
    for (int i = 0; i < 16; ++i) { s0[i] = __builtin_amdgcn_exp2f(s0[i] - mrun); s1[i] = __builtin_amdgcn_exp2f(s1[i] - mrun); ps += s0[i] + s1[i]; }
    lrun += ps;
#pragma unroll
    for (int kt = 0; kt < 2; ++kt)
#pragma unroll
      for (int s = 0; s < 2; ++s) {
        const f32x16& sx = kt ? s1 : s0;
        u32x4 pw; pw.x = pk_bf16(sx[8 * s], sx[8 * s + 1]); pw.y = pk_bf16(sx[8 * s + 2], sx[8 * s + 3]); pw.z = pk_bf16(sx[8 * s + 4], sx[8 * s + 5]); pw.w = pk_bf16(sx[8 * s + 6], sx[8 * s + 7]);
        const bf16x8 pb = __builtin_bit_cast(bf16x8, pw);
        const int ko = 32 * kt + 16 * s + 4 * hh;
        const s16x4 l0 = *(const s16x4*)(Vl + ql * AT_VROW + ko), h0 = *(const s16x4*)(Vl + ql * AT_VROW + ko + 8);
        const s16x4 l1 = *(const s16x4*)(Vl + (32 + ql) * AT_VROW + ko), h1 = *(const s16x4*)(Vl + (32 + ql) * AT_VROW + ko + 8);
        const bf16x8 av0 = __builtin_shufflevector(l0, h0, 0, 1, 2, 3, 4, 5, 6, 7), av1 = __builtin_shufflevector(l1, h1, 0, 1, 2, 3, 4, 5, 6, 7);
        __builtin_amdgcn_s_setprio(1); o0 = MFMA32(av0, pb, o0); o1 = MFMA32(av1, pb, o1); __builtin_amdgcn_s_setprio(0);
      }
    {
      const float mnew = fmaxf(mrun, fmaxf(mx, mxo));
      if (__builtin_amdgcn_ballot_w64(mnew > mrun) != 0ull) {
        const float alpha = __builtin_amdgcn_exp2f(mrun - mnew);
        lrun *= alpha;
#pragma unroll
        for (int i = 0; i < 16; ++i) { o0[i] *= alpha; o1[i] *= alpha; }
        mrun = mnew;
      }
    }
    if (t + 1 < nt) { bf16_t* S1 = (bf16_t*)(lds + ((t + 1) & 1) * AT_STAGE); *(u32x4*)(S1 + kn_dst) = rk; if (tid < 256) *(u32x4*)(S1 + kr_dst) = rr; *(u32x4*)(S1 + vt_dst) = rv; }
    __syncthreads();
  }
  const float linv = 1.f / (lrun + xshfl(lrun, lane, 32));
  const int rout = pq < 256 ? NLAT + b * 256 + pq : b * 4096 + pq - 256;
  bf16_t* yo = (bf16_t*)(ows(P) + OFF_H) + (size_t)rout * 1024 + 512 + h * 64 + 4 * hh;
#pragma unroll
  for (int g4 = 0; g4 < 4; ++g4) {
    u32x2 w0, w1;
    w0.x = pk_bf16(o0[4 * g4] * linv, o0[4 * g4 + 1] * linv); w0.y = pk_bf16(o0[4 * g4 + 2] * linv, o0[4 * g4 + 3] * linv);
    w1.x = pk_bf16(o1[4 * g4] * linv, o1[4 * g4 + 1] * linv); w1.y = pk_bf16(o1[4 * g4 + 2] * linv, o1[4 * g4 + 3] * linv);
    *(u32x2*)(yo + 8 * g4) = w0; *(u32x2*)(yo + 32 + 8 * g4) = w1;
  }
}
#ifndef EN_HY
#define EN_HY 1
#endif
#ifndef EN_SG
#define EN_SG 1
#endif
#ifndef EN_AT
#define EN_AT 1
#endif
#ifndef REP_GEMM
#define REP_GEMM 1
#endif
#ifndef REP_ATTN
#define REP_ATTN 1
#endif
#ifndef REP_HY
#define REP_HY 1
#endif
#ifndef REP_P0
#define REP_P0 1
#endif
#ifndef REP_PREP
#define REP_PREP 1
#endif
#ifndef REP_SGU
#define REP_SGU 1
#endif
#ifndef REP_SYNC
#define REP_SYNC 1
#endif
#ifndef REP_UP
#define REP_UP 1
#endif
#ifndef REP_DOWN
#define REP_DOWN 1
#endif
#ifndef REP_PROJ
#define REP_PROJ 1
#endif
#ifndef REP_OUT
#define REP_OUT 1
#endif
#ifndef REP_QKV
#define REP_QKV 1
#endif
template <class Epi> DI void run_gemm(unsigned char* lds, const bf16_t* A, const bf16_t* Bt, int N, int K, const Epi& E, int wv, int M = MTOT, int reps = 1, int cshift = 0) {
  pg8::Gemm g; g.A = A; g.Bt = Bt; g.M = M; g.N = N; g.K = K;
  pg8::StaticOrder S; S.init(M, N, (int)gridDim.x, (int)((blockIdx.x + cshift) % gridDim.x)); S.ntk = K / 64;
  for (int rep = 0; rep < REP_GEMM * reps; ++rep) { Epi E2 = E; E2.wv = wv; if (rep + 1 < REP_GEMM * reps) E2.kill(); pg8::gemm_phase<Epi, pg8::StaticOrder, false>((LAS unsigned char*)lds, g, S, E2, nullptr, wv); }
}
template <class Epi> DI void run_gemm_split(unsigned char* lds, const bf16_t* A, const bf16_t* Bt, int K, int S_, const Epi& E, int wv, int reps = 1) {
  pg8::Gemm g; g.A = A; g.Bt = Bt; g.M = MTOT; g.N = 1024; g.K = K;
  pg8::SplitOrder S; S.init(K, S_, (int)gridDim.x, (int)blockIdx.x);
  for (int rep = 0; rep < REP_GEMM * reps; ++rep) { Epi E2 = E; E2.wv = wv; E2.ksub = K / S_; if (rep + 1 < REP_GEMM * reps) E2.kill(); pg8::gemm_phase<Epi, pg8::SplitOrder, false>((LAS unsigned char*)lds, g, S, E2, nullptr, wv); }
}
DI void zero_cols(const Params& P, int c0, int wv) {
  for (size_t i = (size_t)blockIdx.x * 512 + otid(wv); i < (size_t)MTOT * 32; i += (size_t)gridDim.x * 512) {
    const size_t r = i >> 5, ch = i & 31; *(u32x4*)((bf16_t*)(P.ws + OFF_H) + r * 1024 + c0 + ch * 8) = (u32x4){0, 0, 0, 0}; }
}
__global__ void __launch_bounds__(512) fwd_megakernel(Params P) {
  cg::grid_group grid = cg::this_grid();
  extern __shared__ __attribute__((aligned(16))) unsigned char lds[];
  const int wv = __builtin_amdgcn_readfirstlane(threadIdx.x >> 6);
  gchar* ws = ows(P);
  bf16_t* H = (bf16_t*)(ws + OFF_H); bf16_t* AFF = (bf16_t*)(ws + OFF_R1);
  if (blockIdx.x == 0) for (int i = threadIdx.x; i < XCD_BAR_WORDS; i += 512) ((unsigned*)(P.ws + OFF_BAR))[i] = 0u;
  if (threadIdx.x < 4) ((LAS unsigned*)((LAS unsigned char*)lds + LDS_ST_OFF))[threadIdx.x] = 0u;
  for (int rep = 0; rep < REP_P0; ++rep) phase0(P, lds, wv);
  grid.sync();
  if (threadIdx.x == 0) (void)xb_add(&((unsigned*)(P.ws + OFF_BAR))[XB_XCNT(xb_xcc_id())], 1u);
  for (int l = 0; l < 2; ++l) {
    const bf16_t* WL = (const bf16_t*)(ws + OFF_W) + (size_t)l * WL_ELEMS;
    const float* mod = (const float*)(ws + OFF_MOD) + (size_t)l * 5 * 9216;
    for (int rep = 0; rep < REP_PREP; ++rep) { if (l == 0) prep_phase<true>(P, l, 0, wv); else prep_phase<false>(P, l, 0, wv, MTOT, 8); }
    for (int rep = 0; rep < REP_SYNC; ++rep) gsync(P, lds, wv);
    { EpiSwiglu E; E.O = AFF; run_gemm(lds, H, WL + WO_UP1, 5632, 1024, E, wv, MTOT, REP_UP); }
    for (int rep = 0; rep < REP_SYNC; ++rep) gsync(P, lds, wv);
    { EpiResid E; E.xb = (bf16_t*)(ws + OFF_XB); E.xc = (float*)(ws + OFF_XC); E.part = (float*)(ws + OFF_PART); E.mod = mod + 2 * 1024; E.coef = 0.5f; run_gemm_split(lds, AFF, WL + WO_D1, DFF, 8, E, wv, REP_DOWN); }
    for (int rep = 0; rep < REP_SYNC; ++rep) gsync(P, lds, wv);
    for (int rep = 0; rep < REP_PREP; ++rep) prep_phase<false>(P, l, 3, wv, MTOT, 8);
    for (int rep = 0; rep < REP_SYNC; ++rep) gsync(P, lds, wv);
    { EpiProj E; E.ws = ws; run_gemm(lds, H, WL + WO_IN, NINP, 1024, E, wv, MTOT, REP_PROJ); }
    for (int rep = 0; rep < REP_SYNC; ++rep) gsync(P, lds, wv);
#if EN_HY
    for (int c = blockIdx.x; c < 256 * REP_HY; c += gridDim.x) hyena_item(P, l, c & 255, (LAS unsigned char*)lds, wv);
#else
    zero_cols(P, 0, wv);
#endif
    __syncthreads();
    for (int rep = 0; rep < REP_SGU; ++rep) { const MixC mc = mixprep_consts(P, l, wv);
    for (int r = blockIdx.x * 8 + wv; r < MTOT; r += gridDim.x * 16) { mixprep_row(P, l, r, wv, mc); if (r + (int)gridDim.x * 8 < MTOT) mixprep_row(P, l, r + gridDim.x * 8, wv, mc); } }
    for (int rep = 0; rep < REP_SYNC; ++rep) gsync(P, lds, wv);
#if EN_SG
    { const int nsg = l == 1 ? 256 : 272;
      for (int it = gridDim.x - 1 - blockIdx.x; it < nsg * REP_SGU; it += gridDim.x) sgu_item(P, l, it % nsg, lds, wv); }
#else
    zero_cols(P, 256, wv);
#endif
    { EpiQ E; E.ws = ws; run_gemm(lds, (const bf16_t*)(ws + OFF_CQN), WL + WO_UQ, 768, 384, E, wv, MTOT, REP_QKV); }
    { EpiKV E; E.ws = ws; run_gemm(lds, (const bf16_t*)(ws + OFF_CKVN), WL + WO_UKV, 1024, 256, E, wv, MTOT, REP_QKV, 52); }
    for (int rep = 0; rep < REP_SYNC; ++rep) gsync(P, lds, wv);
#if EN_AT
    for (int it0 = blockIdx.x; it0 < 544 * REP_ATTN; it0 += gridDim.x) { const int it = it0 % 544;
      int item;
      if (it < 512) { const int c = it & 255, k = it >> 8, xcd = c & 7, slot = c >> 3; item = (16 * k + 2 * xcd + (slot >> 4)) * 17 + 1 + (slot & 15); }
      else item = (it - 512) * 17;
      if (l == 1 && it >= 512) continue; attn_item(P, item, lds, wv); }
#else
    zero_cols(P, 512, wv); zero_cols(P, 768, wv);
#endif
    for (int rep = 0; rep < REP_SYNC; ++rep) gsync(P, lds, wv);
    { EpiResid E; E.xb = (bf16_t*)(ws + OFF_XB); E.xc = (float*)(ws + OFF_XC); E.part = (float*)(ws + OFF_PART); E.mod = mod + 5 * 1024; E.coef = 1.0f; if (l == 1) run_gemm(lds, H, WL + WO_OUT, 1024, 1024, E, wv, NLAT, REP_OUT); else run_gemm_split(lds, H, WL + WO_OUT, 1024, 4, E, wv, REP_OUT); }
    for (int rep = 0; rep < REP_SYNC; ++rep) gsync(P, lds, wv);
    for (int rep = 0; rep < REP_PREP; ++rep) prep_phase<false>(P, l, 6, wv, l == 1 ? NLAT : MTOT, l == 1 ? 0 : 4);
    for (int rep = 0; rep < REP_SYNC; ++rep) gsync(P, lds, wv);
    { EpiSwiglu E; E.O = AFF; run_gemm(lds, H, WL + WO_UP2, 5632, 1024, E, wv, l == 1 ? NLAT : MTOT); }
    for (int rep = 0; rep < REP_SYNC; ++rep) gsync(P, lds, wv);
    { EpiResid E; E.xb = (bf16_t*)(ws + OFF_XB); E.xc = (float*)(ws + OFF_XC); E.part = (float*)(ws + OFF_PART); E.mod = mod + 8 * 1024; E.coef = 0.5f; if (l == 1) run_gemm(lds, AFF, WL + WO_D2, 1024, DFF, E, wv, NLAT); else run_gemm_split(lds, AFF, WL + WO_D2, DFF, 8, E, wv); }
    for (int rep = 0; rep < REP_SYNC; ++rep) gsync(P, lds, wv);
  }
  final_phase(P, wv);
}

extern "C" void kernel_launch(void* const* d_in, const int* in_sizes, int n_in, void* d_out, int out_size, void* d_ws, size_t ws_size, hipStream_t stream) {
  constexpr size_t kDynLds = 150528;
  static int grid_blocks = 0;
  if (!grid_blocks) {
    (void)hipFuncSetAttribute((const void*)fwd_megakernel, hipFuncAttributeMaxDynamicSharedMemorySize, (int)kDynLds);
    int dev = 0, cus = 0, per_cu = 0;
    (void)hipGetDevice(&dev);
    (void)hipDeviceGetAttribute(&cus, hipDeviceAttributeMultiprocessorCount, dev);
    (void)hipOccupancyMaxActiveBlocksPerMultiprocessor(&per_cu, fwd_megakernel, 512, kDynLds);
    grid_blocks = cus > 0 ? cus : 256;
    if (ws_size < WS_END) fprintf(stderr, "workspace too small: %zu < %zu\n", ws_size, (size_t)WS_END);
  }
  Params p{};
  for (int i = 0; i < 32 && i < n_in; ++i) p.in[i] = (const float*)d_in[i];
  p.out = (float*)d_out; p.ws = (char*)d_ws;
  void* args[] = {&p};
  hipError_t e = hipLaunchCooperativeKernel((void*)fwd_megakernel, dim3(grid_blocks), dim3(512), args, kDynLds, stream);
  if (e != hipSuccess) fprintf(stderr, "cooperative launch failed: %s (grid %d)\n", hipGetErrorString(e), grid_blocks);
}
```

```cpp
#include <hip/hip_runtime.h>
#include <hip/hip_cooperative_groups.h>
#include <cstdio>
namespace cg = cooperative_groups;

#define LAS __attribute__((address_space(3)))
#define DI __device__ __forceinline__
typedef unsigned short bf16_t;
typedef short bf16x8 __attribute__((ext_vector_type(8)));
typedef short s16x4 __attribute__((ext_vector_type(4)));
typedef float f32x4 __attribute__((ext_vector_type(4)));
typedef float f32x2 __attribute__((ext_vector_type(2)));
typedef float f32x16 __attribute__((ext_vector_type(16)));
typedef unsigned u32x4 __attribute__((ext_vector_type(4)));
typedef unsigned u32x2 __attribute__((ext_vector_type(2)));
typedef __bf16 bf16x2_t __attribute__((ext_vector_type(2)));

struct Params { const float* in[32]; float* out; char* ws; };

constexpr int NLAT = 16384, MTOT = 17408, DM = 1024, DFF = 2816, NIN = 1952, NINP = 2048, NPOS = 4352;
enum { I_X = 0, I_C, I_CTX, I_CCTX, I_ADAW, I_ADAB, I_F1G, I_F1U, I_F1D, I_WIN, I_WOUT, I_HCW, I_HCB, I_HW1, I_HB1, I_HW2, I_HB2, I_HW3, I_HFREQ, I_HBIAS,
       I_SGG, I_SGB, I_SGW, I_SGBS, I_QN, I_WUQ, I_KVN, I_WUKV, I_F2G, I_F2U, I_F2D, I_FN };
constexpr size_t OFF_XC = 0;
constexpr size_t OFF_H = OFF_XC + (size_t)1024 * 1024 * 4;
constexpr size_t OFF_R1 = OFF_H + (size_t)MTOT * 1024 * 2;
constexpr size_t OFF_PROJ = OFF_R1;
constexpr size_t OFF_PT = OFF_PROJ + (size_t)MTOT * NINP * 2;
constexpr size_t OFF_PTC = OFF_PT + (size_t)4 * 768 * 4096 * 2;
constexpr size_t OFF_Q = OFF_PROJ;
constexpr size_t OFF_KN = OFF_Q + (size_t)32 * NPOS * 96 * 2;
constexpr size_t OFF_VT = OFF_KN + (size_t)32 * NPOS * 64 * 2;
constexpr size_t OFF_R2 = OFF_R1 + (size_t)MTOT * DFF * 2;
constexpr size_t OFF_PART = OFF_R2;
constexpr size_t OFF_CQN = OFF_R2;
constexpr size_t OFF_CKVN = OFF_CQN + (size_t)MTOT * 384 * 2;
constexpr size_t OFF_KR = OFF_CKVN + (size_t)MTOT * 256 * 2;
constexpr size_t OFF_UG = OFF_KR + (size_t)4 * NPOS * 32 * 2;
constexpr size_t OFF_VN = OFF_UG + (size_t)MTOT * 256 * 2;
constexpr size_t OFF_W = OFF_VN + (size_t)MTOT * 256 * 2;
constexpr size_t WO_UP1 = 0, WO_UP2 = 5767168, WO_D1 = 11534336, WO_D2 = 14417920, WO_IN = 17301504, WO_OUT = 19398656, WO_UQ = 20447232, WO_UKV = 20742144, WO_S = 21004288, WL_ELEMS = 21069824;
constexpr size_t OFF_MOD = OFF_W + 2 * WL_ELEMS * 2;
constexpr size_t OFF_H2 = OFF_MOD + (size_t)2 * 5 * 9216 * 4;
constexpr size_t OFF_H2C = OFF_H2 + (size_t)2 * 4096 * 64 * 4;
constexpr size_t OFF_TW = OFF_H2C + (size_t)2 * 256 * 64 * 4;
constexpr size_t OFF_ROPE = OFF_TW + 4096 * 8;
constexpr size_t OFF_XB = OFF_ROPE + 64 * 8 * 8;
constexpr size_t OFF_BAR = OFF_XB + (size_t)NLAT * 1024 * 2;
constexpr size_t WS_END = OFF_BAR + 16384;
static_assert(OFF_VT + (size_t)32 * NPOS * 64 * 2 <= OFF_PT, "alias overflow");
static_assert(OFF_PTC + (size_t)4 * 768 * 256 * 2 <= OFF_R2, "R1 overflow");

DI int otid(int wv) { int ln; asm volatile("v_mbcnt_lo_u32_b32 %0, -1, 0\n\tv_mbcnt_hi_u32_b32 %0, -1, %0" : "=&v"(ln)); return (wv << 6) | ln; }
DI unsigned pk_bf16(float a, float b) { f32x2 v = {a, b}; bf16x2_t r = __builtin_convertvector(v, bf16x2_t); return __builtin_bit_cast(unsigned, r); }
DI bf16_t f2bf(float a) { return (bf16_t)(pk_bf16(a, a) & 0xffffu); }
DI float bf2f(bf16_t u) { return __uint_as_float(((unsigned)u) << 16); }
DI float silu_f(float g) { return g * __builtin_amdgcn_rcpf(1.f + __expf(-g)); }
typedef __attribute__((address_space(1))) char gchar;
DI gchar* ows(const Params& P) {
  const unsigned long long w = (unsigned long long)P.ws; unsigned lo = (unsigned)w, hi = (unsigned)(w >> 32);
  asm volatile("" : "+v"(lo), "+v"(hi));
  lo = __builtin_amdgcn_readfirstlane(lo); hi = __builtin_amdgcn_readfirstlane(hi);
  return (gchar*)(((unsigned long long)hi << 32) | lo);
}
DI float rdlane_c(float v, int i) { return __builtin_bit_cast(float, __builtin_amdgcn_readlane(__builtin_bit_cast(int, v), i)); }
DI float xshfl(float v, int lane, int o) { return __builtin_bit_cast(float, __builtin_amdgcn_ds_bpermute((lane ^ o) << 2, __builtin_bit_cast(int, v))); }
#define DPP_F(v, ctrl) __builtin_bit_cast(float, __builtin_amdgcn_update_dpp(0, __builtin_bit_cast(int, (v)), (ctrl), 0xf, 0xf, true))
DI float wave_sum(float v, int lane) {
  v += DPP_F(v, 0xB1); v += DPP_F(v, 0x4E); v += DPP_F(v, 0x141); v += DPP_F(v, 0x140);
  return (rdlane_c(v, 0) + rdlane_c(v, 16)) + (rdlane_c(v, 32) + rdlane_c(v, 48));
}
DI float gelu_f(float v) {
  const float av = __builtin_fabsf(v), t = __builtin_amdgcn_rcpf(av * 0.2316418882f + 1.0f);
  float q = t * 0.5307027145f + (-0.7265760135f); q = q * t + 0.7107068705f; q = q * t + (-0.142248368f); q = q * t + 0.127414796f; q = q * t;
  const float e = __builtin_amdgcn_exp2f((v * v) * (-0.72134752044f)), m = v * (q * e);
  return v < 0.f ? m : v - m;
}
DI float rdlane(float v, int i) { return __builtin_bit_cast(float, __builtin_amdgcn_readlane(__builtin_bit_cast(int, v), i)); }
DI void row_bp(int r, int& b, int& p) { if (r < NLAT) { b = r >> 12; p = 256 + (r & 4095); } else { const int rc = r - NLAT; b = rc >> 8; p = rc & 255; } }
DI f32x4 bf4_to_f32(u32x2 w) { return (f32x4){__uint_as_float(w.x << 16), __uint_as_float(w.x & 0xffff0000u), __uint_as_float(w.y << 16), __uint_as_float(w.y & 0xffff0000u)}; }
DI u32x2 f32_to_bf4(f32x4 v) { u32x2 w; w.x = pk_bf16(v[0], v[1]); w.y = pk_bf16(v[2], v[3]); return w; }
DI f32x4 xload(const Params& P, int r, int c) {
  if (r < NLAT) return bf4_to_f32(*(const u32x2*)((const bf16_t*)(ows(P) + OFF_XB) + (size_t)r * 1024 + c));
  return *(const f32x4*)((const float*)(ows(P) + OFF_XC) + (size_t)(r - NLAT) * 1024 + c);
}
DI void xstore(const Params& P, int r, int c, f32x4 v) {
  if (r < NLAT) *(u32x2*)((bf16_t*)(ows(P) + OFF_XB) + (size_t)r * 1024 + c) = f32_to_bf4(v);
  else *(f32x4*)((float*)(ows(P) + OFF_XC) + (size_t)(r - NLAT) * 1024 + c) = v;
}

#define XB_TMO      128
#define XB_XCNT(j)  (256  + 64 * (j))
#define XB_XSUB(j)  (1280 + 64 * (j))
#define XB_XGEN(j)  (2304 + 64 * (j))
#define XB_TOP      3328
#define XB_TOPGEN   3392
#define XCD_BAR_WORDS 3456
#define XB_SPIN_CAP (1u << 20)
constexpr int LDS_ST_OFF = 133120;
constexpr int LDS_TW2_OFF = 133632;
DI unsigned xb_ld(unsigned* p) { return __hip_atomic_load(p, __ATOMIC_RELAXED, __HIP_MEMORY_SCOPE_AGENT); }
DI unsigned xb_add(unsigned* p, unsigned v) { return __hip_atomic_fetch_add(p, v, __ATOMIC_RELAXED, __HIP_MEMORY_SCOPE_AGENT); }
DI unsigned xb_xcc_id() { return (unsigned)__builtin_amdgcn_s_getreg((3 << 11) | 20) & 0xFu; }
#define XB_SPIN(cond, bar) do { unsigned _sp = 0; while (cond) { __builtin_amdgcn_s_sleep(1); \
    if ((++_sp & 255u) == 0u) { if (xb_ld(&(bar)[XB_TMO])) break; if (_sp > XB_SPIN_CAP) { atomicAdd(&(bar)[XB_TMO], 1u); break; } } } } while (0)
DI void xcd_barrier_complete(unsigned* bar, unsigned x, unsigned& nloc, unsigned& nx) {
  const unsigned G = gridDim.x;
  unsigned sum, cnt, mine, sp = 0u;
  for (;;) {
    sum = 0u; cnt = 0u; mine = 0u;
#pragma unroll
    for (unsigned j = 0; j < 16; ++j) { const unsigned c = xb_ld(&bar[XB_XCNT(j)]); sum += c; cnt += (c > 0u) ? 1u : 0u; mine = (j == x) ? c : mine; }
    if (sum == G) break;
    __builtin_amdgcn_s_sleep(1);
    if ((++sp & 255u) == 0u) { if (xb_ld(&bar[XB_TMO])) break; if (sp > XB_SPIN_CAP) { atomicAdd(&bar[XB_TMO], 1u); break; } }
  }
  nloc = mine > 0u ? mine : 1u; nx = cnt > 0u ? cnt : 1u;
}
DI void gsync(const Params& P, unsigned char* lds, int wv) {
  asm volatile("s_waitcnt vmcnt(0)" ::: "memory");
  __syncthreads();
  if (wv == 0 && __builtin_amdgcn_mbcnt_lo(~0u, 0u) == 0 && __builtin_amdgcn_mbcnt_hi(~0u, 0u) == 0) {
    unsigned* bar = (unsigned*)(ows(P) + OFF_BAR);
    volatile LAS unsigned* st = (volatile LAS unsigned*)((LAS unsigned char*)lds + LDS_ST_OFF);
    const unsigned x = xb_xcc_id();
    __builtin_amdgcn_s_waitcnt(0);
    unsigned nloc = st[0], nx = st[1];
    if (nloc == 0u) { xcd_barrier_complete(bar, x, nloc, nx); st[0] = nloc; st[1] = nx; }
    const unsigned old = xb_add(&bar[XB_XSUB(x)], 1u);
    const unsigned gen = old / nloc;
    if (old + 1u == (gen + 1u) * nloc) {
      __builtin_amdgcn_fence(__ATOMIC_RELEASE, "agent");
      asm volatile("s_waitcnt vmcnt(0)" ::: "memory");
      const unsigned og = xb_add(&bar[XB_TOP], 1u);
      const unsigned tg = og / nx;
      if (og + 1u == (tg + 1u) * nx) xb_add(&bar[XB_TOPGEN], 1u);
      else XB_SPIN(xb_ld(&bar[XB_TOPGEN]) == tg, bar);
      __builtin_amdgcn_fence(__ATOMIC_ACQUIRE, "agent");
      xb_add(&bar[XB_XGEN(x)], 1u);
      asm volatile("s_waitcnt vmcnt(0)" ::: "memory");
    } else {
      XB_SPIN(xb_ld(&bar[XB_XGEN(x)]) == gen, bar);
      __builtin_amdgcn_fence(__ATOMIC_ACQUIRE, "agent");
      asm volatile("s_waitcnt vmcnt(0)" ::: "memory");
    }
  }
  __syncthreads();
}
namespace pg8 {
#define PG8_LAS __attribute__((address_space(3)))
constexpr int BM = 256, BK = 64, HALF = 128, HTB = HALF * BK * 2  , STAGE_BYTES = 8 * HTB, NXCD = 8, WGM = 4;
__host__ __device__ __forceinline__ int lds_byte(int r, int c) { const int st = (r >> 4) * 2 + (c >> 5), rr = r & 15, cc = c & 31, ob = rr * 64 + cc * 2; return st * 1024 + (ob ^ (((ob >> 9) & 1) << 5)); }
__host__ __device__ __forceinline__ void stage_rc(int b, int& R, int& C) { const int st = b / 1024, sb = b % 1024, swz = sb ^ (((sb >> 9) & 1) << 5); R = (st >> 1) * 16 + swz / 64; C = (st & 1) * 32 + (swz % 64) / 2; }
__host__ __device__ __forceinline__ int perm32(int rho) { const int n = rho >> 4, i = rho & 15; return 8 * (i >> 2) + 4 * n + (i & 3); }

struct Unit { int pm, pn, koff, nt; };
struct Gemm { const bf16_t* A; const bf16_t* Bt; int M, N, K; };
struct StaticOrder {
    int nM, nN, nwg, G, c, ntk;
    __host__ __device__ void init(int M, int N, int G_, int c_) { nM = M / BM; nN = N / BM; nwg = nM * nN; G = G_; c = c_; }
    __host__ __device__ bool next(int i, Unit& u) const {
        const long L = (long)i * G + c; if (L >= nwg) return false;
        int wgid = (int)L; { const int q = nwg / NXCD, r = nwg % NXCD, xcd = wgid % NXCD, off = wgid / NXCD; wgid = (xcd < r ? xcd * (q + 1) : r * (q + 1) + (xcd - r) * q) + off; }
        const int nig = WGM * nN, gid = wgid / nig, fm = gid * WGM, gsz = (nM - fm) < WGM ? (nM - fm) : WGM;
        u.pm = fm + ((wgid % nig) % gsz); u.pn = (wgid % nig) / gsz; u.koff = 0; u.nt = ntk; return true;
    }
    __device__ __forceinline__ void a_ready(const Unit&) const {}
    __device__ __forceinline__ void done(const Unit&) const {}
};
struct SplitOrder {
    StaticOrder lat; int S, ksub, rounds, uneven;
    __device__ void init(int K, int S_, int G_, int c_) { lat.init(16384, 1024, G_, c_); lat.ntk = K / BK; S = S_; ksub = K / S_; rounds = (lat.nwg + G_ - 1) / G_; uneven = (K == 2816 && S_ == 8); }
    __device__ bool next(int i, Unit& u) const {
        const int nlat = lat.c < lat.nwg ? (lat.nwg - lat.c + lat.G - 1) / lat.G : 0;
        if (i < nlat) return lat.next(i, u);
        const int e = (i - nlat) * lat.G + lat.c; if (e >= 16 * S) return false;
        const int j = e / S, s = e - j * S; u.pm = 64 + (j >> 2); u.pn = j & 3;
        if (uneven) { const int q4 = s >> 2, r4 = s & 3; u.koff = (q4 * 22 + r4 * 6) * BK; u.nt = r4 == 3 ? 4 : 6; }
        else { u.koff = s * ksub; u.nt = ksub / BK; }
        return true;
    }
    __device__ __forceinline__ void a_ready(const Unit&) const {}
    __device__ __forceinline__ void done(const Unit&) const {}
};
template <class Epi, class Sched, bool STAMP = false>
__device__ __forceinline__ void gemm_phase(PG8_LAS unsigned char* lds, const Gemm g, const Sched& S, const Epi& E, unsigned long long* stamps, int wv) {
    const int tid = otid(wv), wid = __builtin_amdgcn_readfirstlane(tid >> 6), lane = tid & 63, wr = wid >> 2, wc = wid & 3, fr = lane & 15, fq = lane >> 4;
    const int K = g.K;
#define PG8_STAMP() do {} while (0)
    unsigned voffA[2], voffB[2];
#pragma unroll
    for (int i = 0; i < 2; ++i) { int R, C; stage_rc(tid * 16 + i * 8192, R, C); const int Rb = Epi::PERM ? ((R & ~31) + perm32(R & 31)) : R;
        voffA[i] = (unsigned)(R * K + C) * 2u; voffB[i] = (unsigned)(Rb * K + C) * 2u; }
    const size_t kstep = (size_t)(BK * 2);
    const size_t hstep = (size_t)HALF * K * 2;
    const size_t tstep = 2 * hstep;
    const unsigned ldsw = (unsigned)wid * 1024u;
    const int aoff = lds_byte(wr * 64 + fr, fq * 8), boff = lds_byte(wc * 32 + fr, fq * 8);
#define PG8_SA(b, h) (((b) * 2 + (h)) * HTB)
#define PG8_SB(b, h) ((4 + (b) * 2 + (h)) * HTB)
#define PG8_STAGE(bufoff, gbase, voff) do { _Pragma("unroll") for (int _i = 0; _i < 2; ++_i) \
        __builtin_amdgcn_global_load_lds((const unsigned*)((const char*)(gbase) + (voff)[_i]), (PG8_LAS unsigned*)(lds + (bufoff) + ldsw + _i * 8192), 16, 0, 0); } while (0)
#define PG8_LDA(dst, b, h) do { _Pragma("unroll") for (int m = 0; m < 4; ++m) _Pragma("unroll") for (int k = 0; k < 2; ++k) dst[m][k] = *(const PG8_LAS bf16x8*)(lds + PG8_SA(b, h) + aoff + m * 2048 + k * 1024); } while (0)
#define PG8_LDB(dst, b, h) do { _Pragma("unroll") for (int n = 0; n < 2; ++n) _Pragma("unroll") for (int k = 0; k < 2; ++k) dst[n][k] = *(const PG8_LAS bf16x8*)(lds + PG8_SB(b, h) + boff + n * 2048 + k * 1024); } while (0)
#define PG8_MMA(ai, bj, At, Bt) do { __builtin_amdgcn_s_setprio(1); _Pragma("unroll") for (int m = 0; m < 4; ++m) _Pragma("unroll") for (int n = 0; n < 2; ++n) _Pragma("unroll") for (int k = 0; k < 2; ++k) \
        acc[ai][bj][m][n] = __builtin_amdgcn_mfma_f32_16x16x32_bf16(Bt[n][k], At[m][k], acc[ai][bj][m][n], 0, 0, 0); __builtin_amdgcn_s_setprio(0); } while (0)
#define PG8_WAIT_V(n) asm volatile("s_waitcnt vmcnt(" #n ")" ::: "memory")
#define PG8_WAIT_L(n) asm volatile("s_waitcnt lgkmcnt(" #n ")" ::: "memory")
#define PG8_BAR __builtin_amdgcn_s_barrier()
#define PG8_SCHED __builtin_amdgcn_sched_barrier(0)
    Unit cur, nxt; int ui = 0;
    if (!S.next(0, cur)) return;
    f32x4 acc[2][2][4][2];
#pragma unroll
    for (int a = 0; a < 2; ++a)
#pragma unroll
        for (int b = 0; b < 2; ++b)
#pragma unroll
            for (int m = 0; m < 4; ++m)
#pragma unroll
                for (int n = 0; n < 2; ++n) acc[a][b][m][n] = (f32x4){0.f, 0.f, 0.f, 0.f};
    bf16x8 At[4][2], B0[2][2], B1[2][2];
    const char* cA = (const char*)g.A + (size_t)cur.pm * tstep + (size_t)cur.koff * 2; const char* cB = (const char*)g.Bt + (size_t)cur.pn * tstep + (size_t)cur.koff * 2;
    S.a_ready(cur);
    PG8_STAGE(PG8_SB(0, 0), cB, voffB); PG8_STAGE(PG8_SA(0, 0), cA, voffA); PG8_STAGE(PG8_SB(0, 1), cB + hstep, voffB); PG8_STAGE(PG8_SA(0, 1), cA + hstep, voffA);
    if (wr == 1) PG8_BAR;
    PG8_WAIT_V(4); PG8_BAR;
    PG8_STAGE(PG8_SB(1, 0), cB + kstep, voffB); PG8_STAGE(PG8_SA(1, 0), cA + kstep, voffA); PG8_STAGE(PG8_SB(1, 1), cB + hstep + kstep, voffB);
    PG8_WAIT_V(6); PG8_BAR;
    for (;;) {
        const bool has_next = S.next(ui + 1, nxt);
        const char* nA = has_next ? (const char*)g.A + (size_t)nxt.pm * tstep + (size_t)nxt.koff * 2 : cA; const char* nB = has_next ? (const char*)g.Bt + (size_t)nxt.pn * tstep + (size_t)nxt.koff * 2 : cB;
        const int nt = cur.nt;
        for (int t = 0; t < nt; t += 2) {
            const bool last = (t == nt - 2);
            const char* a1 = cA + (size_t)(t + 1) * kstep;
            const char* a2 = last ? nA : cA + (size_t)(t + 2) * kstep; const char* b2 = last ? nB : cB + (size_t)(t + 2) * kstep;
            const char* a3 = a2 + kstep; const char* b3 = b2 + kstep;
            if (last && has_next) S.a_ready(nxt);
            PG8_LDB(B0, 0, 0); PG8_SCHED; PG8_LDA(At, 0, 0); PG8_STAGE(PG8_SA(1, 1), a1 + hstep, voffA);
            PG8_WAIT_L(8); PG8_BAR; PG8_WAIT_L(0); PG8_MMA(0, 0, At, B0); PG8_BAR; PG8_SCHED;
            PG8_LDB(B1, 0, 1); PG8_STAGE(PG8_SB(0, 0), b2, voffB);
            PG8_BAR; PG8_WAIT_L(0); PG8_MMA(0, 1, At, B1); PG8_BAR;
            PG8_LDA(At, 0, 1); PG8_STAGE(PG8_SA(0, 0), a2, voffA);
            PG8_BAR; PG8_WAIT_L(0); PG8_MMA(1, 0, At, B0); PG8_BAR; PG8_SCHED;
            PG8_STAGE(PG8_SB(0, 1), b2 + hstep, voffB);
            PG8_WAIT_V(6); PG8_BAR; PG8_MMA(1, 1, At, B1); PG8_BAR;
            PG8_LDB(B0, 1, 0); PG8_SCHED; PG8_LDA(At, 1, 0); PG8_STAGE(PG8_SA(0, 1), a2 + hstep, voffA);
            PG8_WAIT_L(8); PG8_BAR; PG8_WAIT_L(0); PG8_MMA(0, 0, At, B0); PG8_BAR; PG8_SCHED;
            PG8_LDB(B1, 1, 1); PG8_STAGE(PG8_SB(1, 0), b3, voffB);
            PG8_BAR; PG8_WAIT_L(0); PG8_MMA(0, 1, At, B1); PG8_BAR;
            PG8_LDA(At, 1, 1); PG8_STAGE(PG8_SA(1, 0), a3, voffA);
            PG8_BAR; PG8_WAIT_L(0); PG8_MMA(1, 0, At, B0); PG8_BAR; PG8_SCHED;
            PG8_STAGE(PG8_SB(1, 1), b3 + hstep, voffB);
            PG8_WAIT_V(6); PG8_BAR; PG8_MMA(1, 1, At, B1); PG8_BAR;
        }
        if constexpr (!Epi::AFTER_DRAIN) { E(acc, cur, wr, wc, fr, fq); S.done(cur); }
        if (!has_next) break;
#pragma unroll
        for (int a = 0; a < 2; ++a)
#pragma unroll
            for (int b = 0; b < 2; ++b)
#pragma unroll
                for (int m = 0; m < 4; ++m)
#pragma unroll
                    for (int n = 0; n < 2; ++n) acc[a][b][m][n] = (f32x4){0.f, 0.f, 0.f, 0.f};
        cur = nxt; cA = nA; cB = nB; ++ui;
    }
    PG8_WAIT_V(0);
    if (wr == 0) PG8_BAR;
    PG8_BAR;
    if constexpr (Epi::AFTER_DRAIN) { E.fused(acc, cur, wr, wc, fr, fq, lds, wid, lane); S.done(cur); }
#undef PG8_STAMP
#undef PG8_SA
#undef PG8_SB
#undef PG8_STAGE
#undef PG8_LDA
#undef PG8_LDB
#undef PG8_MMA
#undef PG8_WAIT_V
#undef PG8_WAIT_L
#undef PG8_BAR
#undef PG8_SCHED
}
}
#ifndef KILL_SKIPS_EPI
#define KILL_SKIPS_EPI 0
#endif
using pg8::Unit; using pg8::HALF; using pg8::BM;
struct EpiSwiglu {
  static constexpr bool PERM = true, AFTER_DRAIN = false;
  bf16_t* O; int wv; int skip = 0;
  DI void kill() { skip = 1; }
  DI void operator()(const f32x4 (&acc)[2][2][4][2], const Unit& u, int wr, int wc, int fr_, int fq_) const {
    const int ln_ = otid(wv) & 63, fr = ln_ & 15, fq = ln_ >> 4;
    if (skip) return;
    const int row0 = u.pm * BM + wr * 64 + fr, col0 = u.pn * 128 + wc * 32 + 8 * fq;
#pragma unroll
    for (int ai = 0; ai < 2; ++ai)
#pragma unroll
      for (int m = 0; m < 4; ++m) {
        const f32x4 g0 = acc[ai][0][m][0], g1 = acc[ai][0][m][1], u0 = acc[ai][1][m][0], u1 = acc[ai][1][m][1];
        u32x4 w;
        w.x = pk_bf16(silu_f(g0[0]) * u0[0], silu_f(g0[1]) * u0[1]); w.y = pk_bf16(silu_f(g0[2]) * u0[2], silu_f(g0[3]) * u0[3]);
        w.z = pk_bf16(silu_f(g1[0]) * u1[0], silu_f(g1[1]) * u1[1]); w.w = pk_bf16(silu_f(g1[2]) * u1[2], silu_f(g1[3]) * u1[3]);
        *(u32x4*)(O + (size_t)(row0 + ai * HALF + m * 16) * DFF + col0) = w;
      }
  }
};
struct EpiResid {
  static constexpr bool PERM = false, AFTER_DRAIN = false;
  bf16_t* xb; float* xc; float* part; const float* mod;
  float coef; int wv; int skip = 0; int ksub = 0;
  DI void kill() { coef = 0.f; skip = KILL_SKIPS_EPI; }
  DI void operator()(const f32x4 (&acc)[2][2][4][2], const Unit& u, int wr, int wc, int fr_, int fq_) const {
    const int ln_ = otid(wv) & 63, fr = ln_ & 15, fq = ln_ >> 4;
    const int row0 = u.pm * BM + wr * 64 + fr, col0 = u.pn * BM + wc * 32 + 4 * fq;
    if (skip) return;
    const int bi = (u.pm < 64) ? (u.pm >> 4) : 4;
    const float* gp = mod + (size_t)bi * 9216 + col0;
    f32x4 gv[2][2];
#pragma unroll
    for (int bj = 0; bj < 2; ++bj)
#pragma unroll
      for (int n = 0; n < 2; ++n) gv[bj][n] = *(const f32x4*)(gp + bj * HALF + n * 16) * coef;
#pragma unroll
    for (int ai = 0; ai < 2; ++ai) {
      f32x4 xv[4][2][2];
      const bool lat = u.pm < 64;
#pragma unroll
      for (int m = 0; m < 4; ++m) {
        const int r = row0 + ai * HALF + m * 16;
        if (!(ksub && u.pm >= 64)) {
#pragma unroll
          for (int bj = 0; bj < 2; ++bj)
#pragma unroll
            for (int n = 0; n < 2; ++n) {
              const int c = col0 + bj * HALF + n * 16;
              xv[m][bj][n] = lat ? bf4_to_f32(*(const u32x2*)(xb + (size_t)r * 1024 + c)) : *(const f32x4*)(xc + (size_t)(r - NLAT) * 1024 + c);
            }
        }
      }
#pragma unroll
      for (int m = 0; m < 4; ++m)
#pragma unroll
        for (int bj = 0; bj < 2; ++bj)
#pragma unroll
          for (int n = 0; n < 2; ++n) {
            const int r = row0 + ai * HALF + m * 16, c = col0 + bj * HALF + n * 16;
            const f32x4 d = gv[bj][n] * acc[ai][bj][m][n];
            if (ksub && u.pm >= 64) *(f32x4*)(part + ((size_t)(u.koff / ksub) * 1024 + (r - NLAT)) * 1024 + c) = d;
            else if (lat) *(u32x2*)(xb + (size_t)r * 1024 + c) = f32_to_bf4(xv[m][bj][n] + d);
            else *(f32x4*)(xc + (size_t)(r - NLAT) * 1024 + c) = xv[m][bj][n] + d;
          }
    }
  }
};
struct EpiProj {
  static constexpr bool PERM = true, AFTER_DRAIN = false;
  gchar* ws; int wv;
  DI void kill() {}
  DI void operator()(const f32x4 (&acc)[2][2][4][2], const Unit& u, int wr, int wc, int fr_, int fq_) const {
    const int ln_ = otid(wv) & 63, fr = ln_ & 15, fq = ln_ >> 4;
    const int row0 = u.pm * BM + wr * 64 + fr, col0 = u.pn * BM + wc * 32 + 8 * fq;
    if (u.pn >= 3) {
      bf16_t* O = (bf16_t*)(ws + OFF_PROJ);
#pragma unroll
      for (int ai = 0; ai < 2; ++ai)
#pragma unroll
        for (int m = 0; m < 4; ++m)
#pragma unroll
          for (int bj = 0; bj < 2; ++bj) {
            const f32x4 v0 = acc[ai][bj][m][0], v1 = acc[ai][bj][m][1];
            u32x4 w; w.x = pk_bf16(v0[0], v0[1]); w.y = pk_bf16(v0[2], v0[3]); w.z = pk_bf16(v1[0], v1[1]); w.w = pk_bf16(v1[2], v1[3]);
            *(u32x4*)(O + (size_t)(row0 + ai * HALF + m * 16) * NINP + col0 + bj * HALF) = w;
          }
    } else {
#pragma unroll
      for (int ai = 0; ai < 2; ++ai)
#pragma unroll
        for (int m = 0; m < 4; ++m) {
          const int r = row0 + ai * HALF + m * 16;
          bf16_t* base; int ld;
          if (r < NLAT) { base = (bf16_t*)(ws + OFF_PT) + (size_t)(r >> 12) * 768 * 4096 + (r & 4095); ld = 4096; }
          else { const int rc = r - NLAT; base = (bf16_t*)(ws + OFF_PTC) + (size_t)(rc >> 8) * 768 * 256 + (rc & 255); ld = 256; }
#pragma unroll
          for (int bj = 0; bj < 2; ++bj)
#pragma unroll
            for (int n = 0; n < 2; ++n)
#pragma unroll
              for (int j = 0; j < 4; ++j) base[(size_t)(col0 + bj * HALF + 4 * n + j) * ld] = f2bf(acc[ai][bj][m][n][j]);
        }
    }
  }
};
struct EpiQ {
  static constexpr bool PERM = false, AFTER_DRAIN = false;
  gchar* ws; int wv;
  DI void kill() {}
  DI void operator()(const f32x4 (&acc)[2][2][4][2], const Unit& u, int wr, int wc, int fr_, int fq_) const {
    const int ln_ = otid(wv) & 63, fr = ln_ & 15, fq = ln_ >> 4;
    const float qs = 0.10206207261596577f * 1.4426950408889634f;
    const int row0 = u.pm * BM + wr * 64 + fr, col0 = u.pn * BM + wc * 32 + 4 * fq;
    bf16_t* Q = (bf16_t*)(ws + OFF_Q);
    const int b = u.pm < 64 ? (u.pm >> 4) : u.pm - 64, p0 = u.pm < 64 ? 256 + ((u.pm & 15) << 8) : 0;
    const f32x2* rope = (const f32x2*)(ws + OFF_ROPE);
#pragma unroll
    for (int ai = 0; ai < 2; ++ai)
#pragma unroll
      for (int m = 0; m < 4; ++m) {
        const int r = row0 + ai * HALF + m * 16, p = p0 + wr * 64 + fr + ai * HALF + m * 16;
#pragma unroll
        for (int bj = 0; bj < 2; ++bj)
#pragma unroll
          for (int n = 0; n < 2; ++n) {
            const int c = col0 + bj * HALF + n * 16, h = c / 96, d = c - h * 96;
            f32x4 v = acc[ai][bj][m][n];
            if (d >= 64 && r < NLAT) {
              const int rp = d - 64, a = rp >> 4, q0 = (rp & 15) >> 1, npos = r & 4095, coord = a ? (npos & 63) : (npos >> 6);
              const f32x2 cs0 = rope[coord * 8 + q0], cs1 = rope[coord * 8 + q0 + 1];
              const f32x4 t = v;
              v[0] = t[0] * cs0.x - t[1] * cs0.y; v[1] = t[1] * cs0.x + t[0] * cs0.y;
              v[2] = t[2] * cs1.x - t[3] * cs1.y; v[3] = t[3] * cs1.x + t[2] * cs1.y;
            }
            u32x2 w; w.x = pk_bf16(v[0] * qs, v[1] * qs); w.y = pk_bf16(v[2] * qs, v[3] * qs);
            *(u32x2*)(Q + ((size_t)(b * 8 + h) * NPOS + p) * 96 + d) = w;
          }
      }
  }
};
struct EpiKV {
  static constexpr bool PERM = false, AFTER_DRAIN = false;
  gchar* ws; int wv;
  DI void kill() {}
  DI void operator()(const f32x4 (&acc)[2][2][4][2], const Unit& u, int wr, int wc, int fr_, int fq_) const {
    const int ln_ = otid(wv) & 63, fr = ln_ & 15, fq = ln_ >> 4;
    const int row0 = u.pm * BM + wr * 64 + fr, col0 = u.pn * BM + wc * 32 + 4 * fq;
    bf16_t* KN = (bf16_t*)(ws + OFF_KN); bf16_t* VT = (bf16_t*)(ws + OFF_VT);
    const int b = u.pm < 64 ? (u.pm >> 4) : u.pm - 64, p0 = u.pm < 64 ? 256 + ((u.pm & 15) << 8) : 0;
#pragma unroll
    for (int ai = 0; ai < 2; ++ai)
#pragma unroll
      for (int m = 0; m < 4; ++m) {
        const int r = row0 + ai * HALF + m * 16, p = p0 + wr * 64 + fr + ai * HALF + m * 16;
#pragma unroll
        for (int bj = 0; bj < 2; ++bj)
#pragma unroll
          for (int n = 0; n < 2; ++n) {
            const int c = col0 + bj * HALF + n * 16, h = c >> 7, d = c & 127;
            const f32x4 v = acc[ai][bj][m][n];
            if (d < 64) { u32x2 w; w.x = pk_bf16(v[0], v[1]); w.y = pk_bf16(v[2], v[3]); *(u32x2*)(KN + ((size_t)(b * 8 + h) * NPOS + p) * 64 + d) = w; }
            else {
#pragma unroll
              for (int j = 0; j < 4; ++j) VT[((size_t)(b * 8 + h) * 64 + (d - 64 + j)) * NPOS + p] = f2bf(v[j]);
            }
          }
      }
  }
};
constexpr int WJ_ND[8] = {5632, 5632, 1024, 1024, 2048, 1024, 768, 1024};
constexpr int WJ_K[8] = {1024, 1024, 2816, 2816, 1024, 1024, 384, 256};
constexpr int WJ_T0[9] = {0, 352, 704, 880, 1056, 1184, 1248, 1266, 1282};
DI size_t wj_off(int j) { return j == 0 ? WO_UP1 : j == 1 ? WO_UP2 : j == 2 ? WO_D1 : j == 3 ? WO_D2 : j == 4 ? WO_IN : j == 5 ? WO_OUT : j == 6 ? WO_UQ : WO_UKV; }
struct WtLoad { f32x4 v[8]; int l, job, r0, k0, K; };
DI WtLoad wt_load(const Params& P, int gt, int tid) {
  WtLoad o;
  const int l = gt / 1282, lt = gt - l * 1282;
  int job = 0;
#pragma unroll
  for (int j = 1; j < 8; ++j) if (lt >= WJ_T0[j]) job = j;
  const int t = lt - WJ_T0[job], K = WJ_K[job], kt = K >> 6, r0 = (t / kt) * 256, k0 = (t % kt) * 64;
  const int tr4 = tid & 63, tk = tid >> 6, r = r0 + 4 * tr4;
  const float* base; int Ns, col = r;
  if (job < 2) { const int tt = r >> 8, bj = (r >> 7) & 1, c = r & 127; col = 128 * tt + c; Ns = DFF;
    base = P.in[job == 0 ? (bj ? I_F1U : I_F1G) : (bj ? I_F2U : I_F2G)] + (size_t)l * 1024 * DFF; }
  else if (job < 4) { base = P.in[job == 2 ? I_F1D : I_F2D] + (size_t)l * DFF * 1024; Ns = 1024; }
  else if (job == 4) { base = P.in[I_WIN] + (size_t)l * 1024 * NIN; Ns = NIN; if (r >= NIN) col = -1; }
  else if (job == 5) { base = P.in[I_WOUT] + (size_t)l * 1024 * 1024; Ns = 1024; }
  else if (job == 6) { base = P.in[I_WUQ] + (size_t)l * 384 * 768; Ns = 768; }
  else { base = P.in[I_WUKV] + (size_t)l * 256 * 1024; Ns = 1024; }
  if (job == 6) {
#pragma unroll
    for (int kk = 0; kk < 8; ++kk)
#pragma unroll
      for (int j = 0; j < 4; ++j) {
        const int rr = r + j, h = rr / 96, d = rr - h * 96; int cc = rr;
        if (d >= 64) { const int rp = d - 64, a = rp >> 4, q = (rp & 15) >> 1, pp = rp & 1; cc = h * 96 + 64 + a * 16 + pp * 8 + q; }
        o.v[kk][j] = base[(size_t)(k0 + tk * 8 + kk) * Ns + cc];
      }
  } else {
#pragma unroll
    for (int kk = 0; kk < 8; ++kk) o.v[kk] = col >= 0 ? __builtin_nontemporal_load((const f32x4*)(base + (size_t)(k0 + tk * 8 + kk) * Ns + col)) : (f32x4){0.f, 0.f, 0.f, 0.f};
  }
  o.l = l; o.job = job; o.r0 = r0; o.k0 = k0; o.K = K;
  return o;
}
DI void wt_store(const Params& P, const WtLoad& o, unsigned char* lds, int tid) {
  const int tr4 = tid & 63, tk = tid >> 6;
  bf16_t* tile = (bf16_t*)lds;
#pragma unroll
  for (int j = 0; j < 4; ++j) {
    u32x4 w; w.x = pk_bf16(o.v[0][j], o.v[1][j]); w.y = pk_bf16(o.v[2][j], o.v[3][j]); w.z = pk_bf16(o.v[4][j], o.v[5][j]); w.w = pk_bf16(o.v[6][j], o.v[7][j]);
    *(u32x4*)(tile + (4 * tr4 + j) * 72 + tk * 8) = w;
  }
  __syncthreads();
  bf16_t* dst = (bf16_t*)(ows(P) + OFF_W) + (size_t)o.l * WL_ELEMS + wj_off(o.job);
#pragma unroll
  for (int i = 0; i < 4; ++i) { const int idx = tid + 512 * i, rr = idx >> 3, ch = idx & 7;
    *(u32x4*)(dst + (size_t)(o.r0 + rr) * o.K + o.k0 + ch * 8) = *(const u32x4*)(tile + rr * 72 + ch * 8); }
  __syncthreads();
}
DI void ada_tile(const Params& P, int t, unsigned char* lds, int wv) {
  const int tid = otid(wv), l = t / 72, j0 = (t % 72) * 128, jl = tid & 31, ks = tid >> 5;
  const float* W = P.in[I_ADAW] + (size_t)l * 1024 * 9216 + j0 + 4 * jl;
  f32x4 acc[5];
#pragma unroll
  for (int bi = 0; bi < 5; ++bi) acc[bi] = (f32x4){0.f, 0.f, 0.f, 0.f};
#pragma unroll 8
  for (int k = ks * 64; k < ks * 64 + 64; ++k) {
    const f32x4 w4 = __builtin_nontemporal_load((const f32x4*)(W + (size_t)k * 9216));
#pragma unroll
    for (int bi = 0; bi < 5; ++bi) { const float cv = bi < 4 ? P.in[I_C][bi * 1024 + k] : P.in[I_CCTX][k]; acc[bi] += w4 * silu_f(cv); }
  }
  float* red = (float*)lds;
#pragma unroll
  for (int bi = 0; bi < 5; ++bi) *(f32x4*)(red + (ks * 5 + bi) * 128 + 4 * jl) = acc[bi];
  __syncthreads();
  for (int o = tid; o < 640; o += 512) {
    const int bi = o >> 7, j = o & 127; float s = 0.f;
#pragma unroll
    for (int k2 = 0; k2 < 16; ++k2) s += red[(k2 * 5 + bi) * 128 + j];
    ((float*)(ows(P) + OFF_MOD))[(size_t)(l * 5 + bi) * 9216 + j0 + j] = s + P.in[I_ADAB][l * 9216 + j0 + j];
  }
  __syncthreads();
}
DI void h2_pos(const Params& P, int idx, int wv) {
  const int lane = otid(wv) & 63;
  const int l = idx / 4352, rem = idx - l * 4352;
  const bool lat = rem < 4096; const int pos = lat ? rem : rem - 4096; const float L = lat ? 4096.f : 256.f;
  const float tn = (float)pos / (L - 1.f), w = 6.2831855f * (float)pos / L;
  float z = 0.f;
  if (lane == 0) z = tn;
  else if (lane < 33) { const int i = (lane - 1) & 15; const float band = 1e-4f + (float)i * ((15.f - 1e-4f) / 15.f), ang = w * band; z = lane < 17 ? cosf(ang) : -sinf(ang); }
  const float* w1 = P.in[I_HW1] + (size_t)l * 33 * 64; const float* w2 = P.in[I_HW2] + (size_t)l * 64 * 64;
  float h1 = P.in[I_HB1][l * 64 + lane];
#pragma unroll
  for (int i = 0; i < 33; ++i) h1 += rdlane(z, i) * w1[i * 64 + lane];
  h1 = sinf(P.in[I_HFREQ][l * 128 + lane] * h1);
  float h2 = P.in[I_HB2][l * 64 + lane];
#pragma unroll
  for (int m = 0; m < 64; ++m) h2 += rdlane(h1, m) * w2[m * 64 + lane];
  h2 = sinf(P.in[I_HFREQ][l * 128 + 64 + lane] * h2);
  float* dst = lat ? (float*)(ows(P) + OFF_H2) + ((size_t)l * 4096 + pos) * 64 : (float*)(ows(P) + OFF_H2C) + ((size_t)l * 256 + pos) * 64;
  dst[lane] = h2;
}
DI void phase0(const Params& P, unsigned char* lds, int wv) {
  const int tid = otid(wv), wave = tid >> 6, nb = gridDim.x, bid = blockIdx.x;
  for (int i = bid * 512 + tid; i < 4096 + 512 + 2 * 65536; i += nb * 512) {
    if (i < 4096) { float s, c; sincospif(-(float)i * (1.f / 4096.f), &s, &c); ((f32x2*)(ows(P) + OFF_TW))[i] = (f32x2){c, s}; }
    else if (i < 4608) { const int k = i - 4096, coord = k >> 3, q = k & 7; const float inv = 1.0f / powf(10000.f, (float)q / 8.f), ang = (float)coord * inv;
      ((f32x2*)(ows(P) + OFF_ROPE))[k] = (f32x2){cosf(ang), sinf(ang)}; }
    else { const int k = i - 4608, l = k >> 16, e = k & 65535; ((bf16_t*)(ows(P) + OFF_W))[(size_t)l * WL_ELEMS + WO_S + e] = f2bf(P.in[I_SGW][k]); }
  }
  for (int t = bid; t < 144; t += nb) ada_tile(P, t, lds, wv);
  for (int i = bid * 8 + wave; i < 8704; i += nb * 8) h2_pos(P, i, wv);
  {
    int t = bid; WtLoad cur; if (t < 2 * 1282) cur = wt_load(P, t, tid);
    while (t < 2 * 1282) { const int tn = t + nb; WtLoad nxt; if (tn < 2 * 1282) nxt = wt_load(P, tn, tid); wt_store(P, cur, lds, tid); cur = nxt; t = tn; }
  }
}
template <bool FIRST> DI void prep_phase(const Params& P, int l, int sidx, int wv, int nrows = MTOT, int nsplit = 0) {
  const int tid = otid(wv), wave = tid >> 6, lane = tid & 63;
  const float* mod = (const float*)(ows(P) + OFF_MOD) + (size_t)l * 5 * 9216;
  bf16_t* H = (bf16_t*)(ows(P) + OFF_H);
  const int stride = gridDim.x * 8;
  int r = blockIdx.x * 8 + wave;
  f32x4 v[4];
  if (r < nrows) {
    if (FIRST) { const float* src = r < NLAT ? P.in[I_X] + (size_t)r * 1024 : P.in[I_CTX] + (size_t)(r - NLAT) * 1024;
#pragma unroll
      for (int i = 0; i < 4; ++i) v[i] = __builtin_nontemporal_load((const f32x4*)(src + i * 256 + lane * 4)); }
    else {
#pragma unroll
      for (int i = 0; i < 4; ++i) v[i] = xload(P, r, i * 256 + lane * 4); }
  }
  f32x4 scc[4], shc[4]; int bic = -1;
  while (r < nrows) {
    const int rn = r + stride; f32x4 vn[4];
    if (rn < nrows) {
      if (FIRST) { const float* src = rn < NLAT ? P.in[I_X] + (size_t)rn * 1024 : P.in[I_CTX] + (size_t)(rn - NLAT) * 1024;
#pragma unroll
        for (int i = 0; i < 4; ++i) vn[i] = __builtin_nontemporal_load((const f32x4*)(src + i * 256 + lane * 4)); }
      else {
#pragma unroll
        for (int i = 0; i < 4; ++i) vn[i] = xload(P, rn, i * 256 + lane * 4); }
    }
    const int bi = r < NLAT ? (r >> 12) : 4;
    if (bi != bic) { const float* sh = mod + (size_t)bi * 9216 + sidx * 1024; const float* sc = sh + 1024; bic = bi;
#pragma unroll
      for (int i = 0; i < 4; ++i) { scc[i] = *(const f32x4*)(sc + i * 256 + lane * 4) + 1.f; shc[i] = *(const f32x4*)(sh + i * 256 + lane * 4); } }
    if (!FIRST && nsplit > 0 && r >= NLAT) {
      const float* pp = (const float*)(ows(P) + OFF_PART) + (size_t)(r - NLAT) * 1024;
      for (int s = 0; s < nsplit; ++s)
#pragma unroll
        for (int i = 0; i < 4; ++i) v[i] += *(const f32x4*)(pp + (size_t)s * 1024 * 1024 + i * 256 + lane * 4);
#pragma unroll
      for (int i = 0; i < 4; ++i) xstore(P, r, i * 256 + lane * 4, v[i]);
    }
    float ss = 0.f;
#pragma unroll
    for (int i = 0; i < 4; ++i) ss += v[i][0] * v[i][0] + v[i][1] * v[i][1] + v[i][2] * v[i][2] + v[i][3] * v[i][3];
    ss = wave_sum(ss, lane);
    const float rs = rsqrtf(ss * (1.f / 1024.f) + 1e-6f);
#pragma unroll
    for (int i = 0; i < 4; ++i) {
      const int c = i * 256 + lane * 4;
      if (FIRST) xstore(P, r, c, v[i]);
      const f32x4 o = v[i] * rs * scc[i] + shc[i];
      u32x2 w; w.x = pk_bf16(o[0], o[1]); w.y = pk_bf16(o[2], o[3]);
      *(u32x2*)(H + (size_t)r * 1024 + c) = w;
    }
#pragma unroll
    for (int i = 0; i < 4; ++i) v[i] = vn[i];
    r = rn;
  }
}
DI void final_phase(const Params& P, int wv) {
  const int tid = otid(wv), wave = tid >> 6, lane = tid & 63;
  const float* fn = P.in[I_FN];
  f32x4 fng[4];
#pragma unroll
  for (int i = 0; i < 4; ++i) fng[i] = *(const f32x4*)(fn + i * 256 + lane * 4);
  const int stride = gridDim.x * 8;
  int r = blockIdx.x * 8 + wave;
  f32x4 v[4];
  if (r < NLAT) {
#pragma unroll
    for (int i = 0; i < 4; ++i) v[i] = xload(P, r, i * 256 + lane * 4); }
  while (r < NLAT) {
    const int rn = r + stride; f32x4 vn[4];
    if (rn < NLAT) {
#pragma unroll
      for (int i = 0; i < 4; ++i) vn[i] = xload(P, rn, i * 256 + lane * 4); }
    float* X = P.out + (size_t)r * 1024;
    float ss = 0.f;
#pragma unroll
    for (int i = 0; i < 4; ++i) ss += v[i][0] * v[i][0] + v[i][1] * v[i][1] + v[i][2] * v[i][2] + v[i][3] * v[i][3];
    ss = wave_sum(ss, lane);
    const float rs = rsqrtf(ss * (1.f / 1024.f) + 1e-6f);
#pragma unroll
    for (int i = 0; i < 4; ++i) __builtin_nontemporal_store(v[i] * rs * fng[i], (f32x4*)(X + i * 256 + lane * 4));
#pragma unroll
    for (int i = 0; i < 4; ++i) v[i] = vn[i];
    r = rn;
  }
}
typedef float cpx __attribute__((ext_vector_type(2)));
#define FD DI
#define CPX_VEC 1
FD int sw(int i) { return i ^ (((i >> 5) & 7) | (((i >> 6) & 3) << 3)); }
#ifdef CPX_VEC
FD cpx cmul(cpx a, cpx b) { return a.xx * b + a.yy * cpx{-b.y, b.x}; }
FD cpx cmulc(cpx a, cpx b) { return a.xx * cpx{b.x, -b.y} + a.yy * b.yx; }
FD cpx cadd(cpx a, cpx b) { return a + b; }
FD cpx csub(cpx a, cpx b) { return a - b; }
#else
FD cpx cmul(cpx a, cpx b) { return cpx{a.x * b.x - a.y * b.y, a.x * b.y + a.y * b.x}; }
FD cpx cmulc(cpx a, cpx b) { return cpx{a.x * b.x + a.y * b.y, a.y * b.x - a.x * b.y}; }
FD cpx cadd(cpx a, cpx b) { return cpx{a.x + b.x, a.y + b.y}; }
FD cpx csub(cpx a, cpx b) { return cpx{a.x - b.x, a.y - b.y}; }
#endif
#ifdef CPX_VEC
#define C8_H(h) const float h = 0.70710678118654752f
#else
#define C8_H(h) const float h = 0.70710678118654752f
#endif
FD cpx cmul_c8(cpx a, int q) {
  if (q == 0) return a;
  if (q == 2) return cpx{a.y, -a.x};
  C8_H(h);
  if (q == 1) return cpx{(a.x + a.y) * h, (a.y - a.x) * h};
  return cpx{(a.y - a.x) * h, -(a.x + a.y) * h};
}
FD void bfly8_dif(cpx (&x)[8], cpx w1) {
  const cpx w2 = cmul(w1, w1), w4 = cmul(w2, w2);
#pragma unroll
  for (int q = 0; q < 4; ++q) { cpx a = x[q], b = x[q + 4]; x[q] = cadd(a, b); x[q + 4] = cmul(cmul_c8(csub(a, b), q), w1); }
#pragma unroll
  for (int hf = 0; hf < 8; hf += 4)
#pragma unroll
    for (int q = 0; q < 2; ++q) { cpx a = x[hf + q], b = x[hf + q + 2]; x[hf + q] = cadd(a, b); x[hf + q + 2] = cmul(cmul_c8(csub(a, b), 2 * q), w2); }
#pragma unroll
  for (int q = 0; q < 8; q += 2) { cpx a = x[q], b = x[q + 1]; x[q] = cadd(a, b); x[q + 1] = cmul(csub(a, b), w4); }
}
template <int HALF = 0, class PT, class PTW> FD void fft_r8_dif(PT W, int lg, PTW TW, int tid) {
  const int len = 1 << lg, e = len >> 3, ts = (8192 >> lg) >> HALF;
  for (int gid = tid; gid < 1024; gid += 512) {
    const int blk = gid >> (lg - 3), j = gid & (e - 1), base = (blk << lg) + j;
    cpx x[8];
#pragma unroll
    for (int q = 0; q < 8; ++q) x[q] = W[sw(base + q * e)];
    bfly8_dif(x, TW[j * ts]);
#pragma unroll
    for (int q = 0; q < 8; ++q) W[sw(base + q * e)] = x[q];
  }
}
FD cpx cmulc_c8(cpx a, int q) {
  if (q == 0) return a;
  if (q == 2) return cpx{-a.y, a.x};
  C8_H(h);
  if (q == 1) return cpx{(a.x - a.y) * h, (a.x + a.y) * h};
  return cpx{-(a.x + a.y) * h, (a.x - a.y) * h};
}
FD void bfly8_dit(cpx (&x)[8], cpx w1) {
  const cpx w2 = cmul(w1, w1), w4 = cmul(w2, w2);
#pragma unroll
  for (int q = 0; q < 8; q += 2) { cpx a = x[q], b = cmulc(x[q + 1], w4); x[q] = cadd(a, b); x[q + 1] = csub(a, b); }
#pragma unroll
  for (int hf = 0; hf < 8; hf += 4)
#pragma unroll
    for (int q = 0; q < 2; ++q) { cpx a = x[hf + q], b = cmulc_c8(cmulc(x[hf + q + 2], w2), 2 * q); x[hf + q] = cadd(a, b); x[hf + q + 2] = csub(a, b); }
#pragma unroll
  for (int q = 0; q < 4; ++q) { cpx a = x[q], b = cmulc_c8(cmulc(x[q + 4], w1), q); x[q] = cadd(a, b); x[q + 4] = csub(a, b); }
}
template <int HALF = 0, class PT, class PTW> FD void ifft_r8_dit(PT W, int lg, PTW TW, int tid) {
  const int len = 1 << lg, e = len >> 3, ts = (8192 >> lg) >> HALF;
  for (int gid = tid; gid < 1024; gid += 512) {
    const int blk = gid >> (lg - 3), j = gid & (e - 1), base = (blk << lg) + j;
    cpx x[8];
#pragma unroll
    for (int q = 0; q < 8; ++q) x[q] = W[sw(base + q * e)];
    bfly8_dit(x, TW[j * ts]);
#pragma unroll
    for (int q = 0; q < 8; ++q) W[sw(base + q * e)] = x[q];
  }
}
template <class PT> FD void fft_r2_first(PT W, const cpx* TW, int tid) {
  for (int i = tid; i < 4096; i += 512) { cpx a = W[sw(i)], b = W[sw(i + 4096)]; W[sw(i)] = cadd(a, b); W[sw(i + 4096)] = cmul(csub(a, b), TW[i]); }
}
FD int brev13(int x) {
  unsigned v = (unsigned)x; v = ((v >> 1) & 0x55555555u) | ((v & 0x55555555u) << 1); v = ((v >> 2) & 0x33333333u) | ((v & 0x33333333u) << 2);
  v = ((v >> 4) & 0x0F0F0F0Fu) | ((v & 0x0F0F0F0Fu) << 4); v = ((v >> 8) & 0x00FF00FFu) | ((v & 0x00FF00FFu) << 8); v = (v >> 16) | (v << 16); return (int)(v >> 19);
}
template <class PT, class PF> FD void spec_mul(PT W, PF F, int o, int tid) {
  for (int pos = tid; pos < 8192; pos += 512) {
    const int k = brev13(pos), kn = (8192 - k) & 8191, posn = brev13(kn);
    const cpx Z = F[sw(pos)], Zn = F[sw(posn)];
    cpx kf;
    if (o == 0) kf = cpx{0.5f * (Z.x + Zn.x), 0.5f * (Z.y - Zn.y)};
    else        kf = cpx{0.5f * (Z.y + Zn.y), -0.5f * (Z.x - Zn.x)};
    W[sw(pos)] = cmul(W[sw(pos)], kf);
  }
}
#define MFMA32(a, b, c) __builtin_amdgcn_mfma_f32_32x32x16_bf16((a), (b), (c), 0, 0, 0)
struct MixC { float qn[6], kvn[4]; f32x4 g4, b4; };
DI MixC mixprep_consts(const Params& P, int l, int wv) {
  const int lane = otid(wv) & 63; MixC c;
#pragma unroll
  for (int i = 0; i < 6; ++i) c.qn[i] = P.in[I_QN][l * 384 + lane + 64 * i];
#pragma unroll
  for (int i = 0; i < 4; ++i) c.kvn[i] = P.in[I_KVN][l * 256 + lane + 64 * i];
  c.g4 = *(const f32x4*)(P.in[I_SGG] + l * 256 + 4 * lane); c.b4 = *(const f32x4*)(P.in[I_SGB] + l * 256 + 4 * lane);
  return c;
}
DI void mixprep_row(const Params& P, int l, int r, int wv, const MixC& C) {
  const int lane = otid(wv) & 63;
  const bf16_t* pr = (const bf16_t*)(ows(P) + OFF_PROJ) + (size_t)r * NINP;
  float q[6], k[4];
#pragma unroll
  for (int i = 0; i < 6; ++i) q[i] = bf2f(pr[1280 + lane + 64 * i]);
#pragma unroll
  for (int i = 0; i < 4; ++i) k[i] = bf2f(pr[1664 + lane + 64 * i]);
  const u32x2 ru = *(const u32x2*)(pr + 768 + 4 * lane), rv2 = *(const u32x2*)(pr + 1024 + 4 * lane);
  const int a = (lane >> 4) & 1, qq = (lane & 15) >> 1, pp = lane & 1;
  const float xs = bf2f(pr[1920 + a * 16 + pp * 8 + qq]), xp = bf2f(pr[1920 + a * 16 + (1 - pp) * 8 + qq]);
  f32x2 cs = {1.f, 0.f};
  if (r < NLAT) { const int npos = r & 4095, coord = a ? (npos & 63) : (npos >> 6); cs = ((const f32x2*)(ows(P) + OFF_ROPE))[coord * 8 + qq]; }
  float ss = 0.f;
#pragma unroll
  for (int i = 0; i < 6; ++i) ss += q[i] * q[i];
  ss = wave_sum(ss, lane);
  float rs = rsqrtf(ss * (1.f / 384.f) + 1e-6f);
  bf16_t* cq = (bf16_t*)(ows(P) + OFF_CQN) + (size_t)r * 384;
#pragma unroll
  for (int i = 0; i < 6; ++i) cq[lane + 64 * i] = f2bf(q[i] * rs * C.qn[i]);
  ss = 0.f;
#pragma unroll
  for (int i = 0; i < 4; ++i) ss += k[i] * k[i];
  ss = wave_sum(ss, lane);
  rs = rsqrtf(ss * (1.f / 256.f) + 1e-6f);
  bf16_t* ck = (bf16_t*)(ows(P) + OFF_CKVN) + (size_t)r * 256;
#pragma unroll
  for (int i = 0; i < 4; ++i) ck[lane + 64 * i] = f2bf(k[i] * rs * C.kvn[i]);
  {
    const float u0 = gelu_f(__uint_as_float(ru.x << 16)), u1 = gelu_f(__uint_as_float(ru.x & 0xffff0000u)), u2 = gelu_f(__uint_as_float(ru.y << 16)), u3 = gelu_f(__uint_as_float(ru.y & 0xffff0000u));
    float v[4] = {gelu_f(__uint_as_float(rv2.x << 16)), gelu_f(__uint_as_float(rv2.x & 0xffff0000u)), gelu_f(__uint_as_float(rv2.y << 16)), gelu_f(__uint_as_float(rv2.y & 0xffff0000u))};
    const float mu = wave_sum(v[0] + v[1] + v[2] + v[3], lane) * (1.f / 256.f);
    float d2 = 0.f;
#pragma unroll
    for (int j = 0; j < 4; ++j) { v[j] -= mu; d2 += v[j] * v[j]; }
    const float rs2 = rsqrtf(wave_sum(d2, lane) * (1.f / 256.f) + 1e-6f);
    u32x2 wu, wv2; wu.x = pk_bf16(u0, u1); wu.y = pk_bf16(u2, u3);
    wv2.x = pk_bf16(v[0] * rs2 * C.g4[0] + C.b4[0], v[1] * rs2 * C.g4[1] + C.b4[1]); wv2.y = pk_bf16(v[2] * rs2 * C.g4[2] + C.b4[2], v[3] * rs2 * C.g4[3] + C.b4[3]);
    *(u32x2*)((bf16_t*)(ows(P) + OFF_UG) + (size_t)r * 256 + 4 * lane) = wu;
    *(u32x2*)((bf16_t*)(ows(P) + OFF_VN) + (size_t)r * 256 + 4 * lane) = wv2;
  }
  if (lane < 32) {
    const float o = r < NLAT ? (pp ? xs * cs.x + xp * cs.y : xs * cs.x - xp * cs.y) : xs;
    int b, p; row_bp(r, b, p);
    ((bf16_t*)(ows(P) + OFF_KR))[((size_t)b * NPOS + p) * 32 + lane] = f2bf(o);
  }
}
DI void sgu_item(const Params& P, int l, int item, unsigned char* lds, int wv) {
  const int tid = otid(wv), wave = tid >> 6, lane = tid & 63, ci = item >> 1, gp = item & 1, r0 = ci * 128;
  const bf16_t* VN = (const bf16_t*)(ows(P) + OFF_VN); const bf16_t* UG = (const bf16_t*)(ows(P) + OFF_UG);
  bf16_t* vT = (bf16_t*)lds;
#pragma unroll
  for (int i = 0; i < 4; ++i) {
    const int e = tid + 512 * i, q = e >> 4, c8 = (e & 15) * 8;
    const u32x4 raw = *(const u32x4*)(VN + (size_t)(r0 + q) * 256 + gp * 128 + c8);
    const unsigned w[4] = {raw.x, raw.y, raw.z, raw.w};
#pragma unroll
    for (int j = 0; j < 4; ++j) { vT[(c8 + 2 * j) * 136 + q] = (bf16_t)(w[j] & 0xffffu); vT[(c8 + 2 * j + 1) * 136 + q] = (bf16_t)(w[j] >> 16); }
  }
  __syncthreads();
  const int ql = lane & 31, hh = lane >> 5, gl = wave >> 2, g = 2 * gp + gl, chl = gl * 64 + (wave & 1) * 32 + ql, pt0 = ((wave >> 1) & 1) * 2;
  const bf16_t* Ws = (const bf16_t*)(ows(P) + OFF_W) + (size_t)l * WL_ELEMS + WO_S + (size_t)g * 128 * 128;
  f32x16 acc[2];
#pragma unroll
  for (int pt = 0; pt < 2; ++pt)
#pragma unroll
    for (int i = 0; i < 16; ++i) acc[pt][i] = 0.f;
#pragma unroll
  for (int s = 0; s < 8; ++s) {
    const bf16x8 bfr = *(const bf16x8*)(vT + chl * 136 + 16 * s + 8 * hh);
#pragma unroll
    for (int pt = 0; pt < 2; ++pt) {
      const bf16x8 afr = *(const bf16x8*)(Ws + (size_t)(32 * (pt0 + pt) + ql) * 128 + 16 * s + 8 * hh);
      acc[pt] = MFMA32(afr, bfr, acc[pt]);
    }
  }
  bf16_t* YC = (bf16_t*)(ows(P) + OFF_H);
  const float* bs = P.in[I_SGBS] + (size_t)l * 512 + g * 128;
  const int chg = gp * 128 + chl;
#pragma unroll
  for (int pt = 0; pt < 2; ++pt)
#pragma unroll
    for (int i = 0; i < 16; ++i) {
      const int p = 32 * (pt0 + pt) + (i & 3) + 8 * (i >> 2) + 4 * hh;
      const float u = bf2f(UG[(size_t)(r0 + p) * 256 + chg]);
      YC[(size_t)(r0 + p) * 1024 + 256 + chg] = f2bf(u * (acc[pt][i] + bs[p]));
    }
  __syncthreads();
}
DI float sconv(const bf16_t* p, int t, int L, float w0, float w1, float w2, float bb) {
  const float a = t > 0 ? bf2f(p[t - 1]) : 0.f, b = bf2f(p[t]), c = t < L - 1 ? bf2f(p[t + 1]) : 0.f;
  return w0 * a + w1 * b + w2 * c + bb;
}
DI void hyena_item(const Params& P, int l, int c, LAS unsigned char* lds, int wv) {
  const int tid = otid(wv);
  LAS cpx* W = (LAS cpx*)lds; LAS cpx* F = W + 8192; LAS float* w3s = (LAS float*)(F + 8192);
  LAS cpx* TW2 = (LAS cpx*)(lds + LDS_TW2_OFF);
  asm volatile("" : "+v"(F), "+v"(w3s), "+v"(TW2));
  const cpx* TW = (const cpx*)(ows(P) + OFF_TW);
#pragma unroll
  for (int i = 0; i < 4; ++i) TW2[tid + 512 * i] = TW[2 * (tid + 512 * i)];
  if (tid < 256) w3s[tid] = P.in[I_HW3][(size_t)l * 64 * 1024 + (tid & 63) * 1024 + (tid >> 6) * 256 + c];
  const float delta = 3.0701134573f + (float)c * ((15.350567286f - 3.0701134573f) / 255.f);
  const float* cwp = P.in[I_HCW] + (size_t)l * 3 * 768; const float* cbp = P.in[I_HCB] + (size_t)l * 768;
  float cw[3][3], cb[3];
#pragma unroll
  for (int k = 0; k < 3; ++k) { cb[k] = cbp[k * 256 + c];
#pragma unroll
    for (int j = 0; j < 3; ++j) cw[k][j] = cwp[j * 768 + k * 256 + c]; }
  const float bias0 = P.in[I_HBIAS][l * 512 + c], bias1 = P.in[I_HBIAS][l * 512 + 256 + c];
  bf16_t* YC = (bf16_t*)(ows(P) + OFF_H);
  __syncthreads();
#ifndef HYP_A
#define HYP_A 1
#endif
#ifndef HYP_B
#define HYP_B 1
#endif
#ifndef HYP_C
#define HYP_C 1
#endif
  for (int repa = 0; repa < HYP_A; ++repa)
  if (l == 0) {
    LAS float* kc = (LAS float*)W; LAS float* vb = kc + 1024; LAS float* v1b = vb + 1024;
    const float* H2C = (const float*)(ows(P) + OFF_H2C) + (size_t)l * 256 * 64;
    if (tid < 256) {
      const int t = tid; float d[4] = {0.f, 0.f, 0.f, 0.f};
      f32x4 hrow[16];
#pragma unroll
      for (int m4 = 0; m4 < 16; ++m4) hrow[m4] = *(const f32x4*)(H2C + t * 64 + 4 * m4);
#pragma unroll
      for (int m4 = 0; m4 < 16; ++m4)
#pragma unroll
        for (int od = 0; od < 4; ++od) { const f32x4 w = *(LAS const f32x4*)(w3s + od * 64 + 4 * m4); d[od] += hrow[m4][0] * w[0] + hrow[m4][1] * w[1] + hrow[m4][2] * w[2] + hrow[m4][3] * w[3]; }
      const float win = __expf(-((float)t / 255.f) * delta) + 0.05f;
      if (t == 0) { kc[255] = (d[0] + d[1]) * win; kc[512 + 255] = (d[2] + d[3]) * win; }
      else { kc[255 + t] = d[0] * win; kc[255 - t] = d[1] * win; kc[512 + 255 + t] = d[2] * win; kc[512 + 255 - t] = d[3] * win; }
    }
    const int cb_ = (tid >> 6) & 3, t0 = (tid & 63) * 4;
    const bf16_t* pbc = (const bf16_t*)(ows(P) + OFF_PTC) + (size_t)cb_ * 768 * 256;
    float x1r[4], x2r[4], vr[4], v1r[4];
    if (tid < 256) {
#pragma unroll
      for (int i = 0; i < 4; ++i) {
        x1r[i] = sconv(pbc + (size_t)c * 256, t0 + i, 256, cw[0][0], cw[0][1], cw[0][2], cb[0]);
        x2r[i] = sconv(pbc + (size_t)(256 + c) * 256, t0 + i, 256, cw[1][0], cw[1][1], cw[1][2], cb[1]);
        vr[i] = sconv(pbc + (size_t)(512 + c) * 256, t0 + i, 256, cw[2][0], cw[2][1], cw[2][2], cb[2]);
        vb[cb_ * 256 + t0 + i] = vr[i];
      }
    }
    __syncthreads();
#pragma unroll
    for (int o = 0; o < 2; ++o) {
      if (tid < 256) {
        LAS const float* src = o ? v1b : vb; LAS const float* kk = kc + o * 512 + 255 + t0;
        float y[4] = {0.f, 0.f, 0.f, 0.f};
        for (int s4 = 0; s4 < 64; ++s4) {
          const f32x4 u4 = *(LAS const f32x4*)(src + cb_ * 256 + 4 * s4);
          float kv[7];
#pragma unroll
          for (int j = 0; j < 7; ++j) kv[j] = kk[j - 3 - 4 * s4];
#pragma unroll
          for (int i = 0; i < 4; ++i)
#pragma unroll
            for (int j = 0; j < 4; ++j) y[i] += kv[3 + i - j] * u4[j];
        }
        if (o == 0) {
#pragma unroll
          for (int i = 0; i < 4; ++i) { v1r[i] = x1r[i] * (y[i] + vr[i] * bias0); v1b[cb_ * 256 + t0 + i] = v1r[i]; }
        } else {
#pragma unroll
          for (int i = 0; i < 4; ++i) YC[(size_t)(NLAT + cb_ * 256 + t0 + i) * 1024 + c] = f2bf(x2r[i] * (y[i] + v1r[i] * bias1));
        }
      }
      __syncthreads();
    }
  }
  for (int repb = 0; repb < HYP_B; ++repb)
  {
    const float* H2 = (const float*)(ows(P) + OFF_H2) + (size_t)l * 4096 * 64;
    LAS float* tile = (LAS float*)W; LAS float* Ff = (LAS float*)F;
    const int tl = tid & 127, od = tid >> 7;
    if (tid < 2) { float z0 = 0.f; asm volatile("" : "+v"(z0)); F[sw(tid * 4096)] = cpx{z0, z0}; }
    f32x4 w4[16];
#pragma unroll
    for (int m4 = 0; m4 < 16; ++m4) w4[m4] = *(LAS const f32x4*)(w3s + od * 64 + 4 * m4);
    f32x4 stg[4];
#pragma unroll
    for (int i = 0; i < 4; ++i) { const int e = tid + 512 * i; stg[i] = *(const f32x4*)(H2 + (size_t)(e >> 4) * 64 + 4 * (e & 15)); }
#pragma unroll 1
    for (int t0 = 0; t0 < 4096; t0 += 128) {
#pragma unroll
      for (int i = 0; i < 4; ++i) { const int e = tid + 512 * i, row = e >> 4, c4 = e & 15; *(LAS f32x4*)(tile + row * 68 + 4 * c4) = stg[i]; }
      if (t0 + 128 < 4096) {
#pragma unroll
        for (int i = 0; i < 4; ++i) { const int e = tid + 512 * i; stg[i] = *(const f32x4*)(H2 + (size_t)(t0 + 128 + (e >> 4)) * 64 + 4 * (e & 15)); }
      }
      __syncthreads();
      float d = 0.f;
#pragma unroll
      for (int m4 = 0; m4 < 16; ++m4) { const f32x4 hv = *(LAS const f32x4*)(tile + tl * 68 + 4 * m4); d += hv[0] * w4[m4][0] + hv[1] * w4[m4][1] + hv[2] * w4[m4][2] + hv[3] * w4[m4][3]; }
      const int t = t0 + tl;
      d *= __expf(-((float)t / 4095.f) * delta) + 0.05f;
      if (t == 0) atomicAdd((float*)(Ff + 2 * sw(0) + (od >> 1)), d);
      else Ff[2 * sw((od & 1) ? 8192 - t : t) + (od >> 1)] = d;
      __syncthreads();
    }
    __syncthreads();
    fft_r2_first(F, TW, tid); __syncthreads();
    fft_r8_dif<1>(F, 12, TW2, tid); __syncthreads(); fft_r8_dif<1>(F, 9, TW2, tid); __syncthreads(); fft_r8_dif<1>(F, 6, TW2, tid); __syncthreads(); fft_r8_dif<1>(F, 3, TW2, tid); __syncthreads();
  }
  for (int bp_ = 0; bp_ < 2 * HYP_C; ++bp_) { const int bp = bp_ & 1;
    float v[8][2];
    const bf16_t* pb0 = (const bf16_t*)(ows(P) + OFF_PT) + (size_t)(2 * bp) * 768 * 4096; const bf16_t* pb1 = pb0 + (size_t)768 * 4096;
#pragma unroll
    for (int i = 0; i < 8; ++i) {
      const int t = tid + 512 * i;
      v[i][0] = sconv(pb0 + (size_t)(512 + c) * 4096, t, 4096, cw[2][0], cw[2][1], cw[2][2], cb[2]);
      v[i][1] = sconv(pb1 + (size_t)(512 + c) * 4096, t, 4096, cw[2][0], cw[2][1], cw[2][2], cb[2]);
    }
#pragma unroll
    for (int o = 0; o < 2; ++o) {
      float gt[8][2];
#pragma unroll
      for (int i = 0; i < 8; ++i) {
        const int t = tid + 512 * i;
        gt[i][0] = sconv(pb0 + (size_t)(o * 256 + c) * 4096, t, 4096, cw[o][0], cw[o][1], cw[o][2], cb[o]);
        gt[i][1] = sconv(pb1 + (size_t)(o * 256 + c) * 4096, t, 4096, cw[o][0], cw[o][1], cw[o][2], cb[o]);
      }
      int t2 = tid; asm volatile("" : "+v"(t2));
      const cpx w12 = TW2[t2];
      {
        cpx lo[8];
#pragma unroll
        for (int q = 0; q < 8; ++q) lo[q] = cpx{v[q][0], v[q][1]};
        bfly8_dif(lo, w12);
#pragma unroll
        for (int q = 0; q < 8; ++q) W[sw(tid + 512 * q)] = lo[q];
        __builtin_amdgcn_sched_barrier(0);
#pragma unroll
        for (int q = 0; q < 8; ++q) lo[q] = cmul(cpx{v[q][0], v[q][1]}, TW[t2 + 512 * q]);
        bfly8_dif(lo, w12);
#pragma unroll
        for (int q = 0; q < 8; ++q) W[sw(4096 + tid + 512 * q)] = lo[q];
      }
      __syncthreads();
      fft_r8_dif<1>(W, 9, TW2, tid); __syncthreads(); fft_r8_dif<1>(W, 6, TW2, tid); __syncthreads(); fft_r8_dif<1>(W, 3, TW2, tid); __syncthreads();
      spec_mul(W, F, o, tid); __syncthreads();
      ifft_r8_dit<1>(W, 3, TW2, tid); __syncthreads(); ifft_r8_dit<1>(W, 6, TW2, tid); __syncthreads(); ifft_r8_dit<1>(W, 9, TW2, tid); __syncthreads();
      const float bo = o ? bias1 : bias0;
      cpx rlo[8], rup[8];
#pragma unroll
      for (int q = 0; q < 8; ++q) rlo[q] = W[sw(tid + 512 * q)];
      bfly8_dit(rlo, w12);
      __builtin_amdgcn_sched_barrier(0);
#pragma unroll
      for (int q = 0; q < 8; ++q) rup[q] = W[sw(4096 + tid + 512 * q)];
      bfly8_dit(rup, w12);
      int tq = tid; asm volatile("" : "+v"(tq));
#pragma unroll
      for (int i = 0; i < 8; ++i) {
        const int t = tid + 512 * i;
        cpx r = cadd(rlo[i], cmulc(rup[i], TW[tq + 512 * i])); r.x *= (1.f / 8192.f); r.y *= (1.f / 8192.f);
        const float g0 = gt[i][0], g1 = gt[i][1];
        if (o == 0) { v[i][0] = g0 * (r.x + v[i][0] * bo); v[i][1] = g1 * (r.y + v[i][1] * bo); }
        else {
          YC[(size_t)((2 * bp) * 4096 + t) * 1024 + c] = f2bf(g0 * (r.x + v[i][0] * bo));
          YC[(size_t)((2 * bp + 1) * 4096 + t) * 1024 + c] = f2bf(g1 * (r.y + v[i][1] * bo));
        }
      }
      __syncthreads();
#ifdef HYP_FFT
      for (int rp = 0; rp < HYP_FFT; ++rp) {
        fft_r8_dif<1>(W, 12, TW2, tid); __syncthreads(); fft_r8_dif<1>(W, 9, TW2, tid); __syncthreads(); fft_r8_dif<1>(W, 6, TW2, tid); __syncthreads(); fft_r8_dif<1>(W, 3, TW2, tid); __syncthreads();
        ifft_r8_dit<1>(W, 3, TW2, tid); __syncthreads(); ifft_r8_dit<1>(W, 6, TW2, tid); __syncthreads(); ifft_r8_dit<1>(W, 9, TW2, tid); __syncthreads(); ifft_r8_dit<1>(W, 12, TW2, tid); __syncthreads();
      }
#endif
    }
  }
}
constexpr int AT_KROW = 104, AT_VROW = 72, AT_STAGE = (64 * AT_KROW + 64 * AT_VROW) * 2;
DI void attn_item(const Params& P, int item, unsigned char* lds, int wv) {
  const int tid = otid(wv), wave = tid >> 6, lane = tid & 63, ql = lane & 31, hh = lane >> 5;
  const int qb = item % 17, bh = item / 17, b = bh >> 3, h = bh & 7;
  const int nt = qb == 0 ? 4 : 68;
  const int pq = qb * 256 + wave * 32 + ql;
  const bf16_t* qptr = (const bf16_t*)(ows(P) + OFF_Q) + ((size_t)bh * NPOS + pq) * 96 + 8 * hh;
  bf16x8 qf[6];
#pragma unroll
  for (int s = 0; s < 6; ++s) qf[s] = *(const bf16x8*)(qptr + 16 * s);
  const bf16_t* kn_src = (const bf16_t*)(ows(P) + OFF_KN) + ((size_t)bh * NPOS + (tid >> 3)) * 64 + (tid & 7) * 8;
  const bf16_t* kr_src = (const bf16_t*)(ows(P) + OFF_KR) + ((size_t)b * NPOS + ((tid & 255) >> 2)) * 32 + (tid & 3) * 8;
  const bf16_t* vt_src = (const bf16_t*)(ows(P) + OFF_VT) + ((size_t)bh * 64 + (tid >> 3)) * NPOS + (tid & 7) * 8;
  const int kn_dst = (tid >> 3) * AT_KROW + (tid & 7) * 8, kr_dst = ((tid & 255) >> 2) * AT_KROW + 64 + (tid & 3) * 8, vt_dst = 64 * AT_KROW + (tid >> 3) * AT_VROW + (tid & 7) * 8;
  u32x4 rk, rr = {0, 0, 0, 0}, rv;
  rk = *(const u32x4*)kn_src; if (tid < 256) rr = *(const u32x4*)kr_src; rv = *(const u32x4*)vt_src;
  { bf16_t* S0 = (bf16_t*)lds; *(u32x4*)(S0 + kn_dst) = rk; if (tid < 256) *(u32x4*)(S0 + kr_dst) = rr; *(u32x4*)(S0 + vt_dst) = rv; }
  __syncthreads();
  f32x16 o0, o1;
#pragma unroll
  for (int i = 0; i < 16; ++i) { o0[i] = 0.f; o1[i] = 0.f; }
  float mrun = -1e30f, lrun = 0.f;
  if (wv >= 4) __builtin_amdgcn_s_setprio(1);
  for (int t = 0; t < nt; ++t) {
    if (t + 1 < nt) { rk = *(const u32x4*)(kn_src + (size_t)(t + 1) * 64 * 64); if (tid < 256) rr = *(const u32x4*)(kr_src + (size_t)(t + 1) * 64 * 32); rv = *(const u32x4*)(vt_src + (t + 1) * 64); }
    const bf16_t* Kl = (const bf16_t*)(lds + (t & 1) * AT_STAGE); const bf16_t* Vl = Kl + 64 * AT_KROW;
    f32x16 s0, s1;
#pragma unroll
    for (int i = 0; i < 16; ++i) { s0[i] = 0.f; s1[i] = 0.f; }
#pragma unroll
    for (int s = 0; s < 6; ++s) {
      const bf16x8 a0 = *(const bf16x8*)(Kl + ql * AT_KROW + 16 * s + 8 * hh), a1 = *(const bf16x8*)(Kl + (32 + ql) * AT_KROW + 16 * s + 8 * hh);
      s0 = MFMA32(a0, qf[s], s0); s1 = MFMA32(a1, qf[s], s1);
    }
    float mx = s0[0];
#pragma unroll
    for (int i = 0; i < 16; ++i) mx = fmaxf(mx, fmaxf(s0[i], s1[i]));
    const float mxo = xshfl(mx, lane, 32);
    if (t == 0) mrun = fmaxf(mx, mxo);
    float ps = 0.f;
#pragma unroll
    for (int i = 0; i < 16; ++i) { s0[i] = __builtin_amdgcn_exp2f(s0[i] - mrun); s1[i] = __builtin_amdgcn_exp2f(s1[i] - mrun); ps += s0[i] + s1[i]; }
    lrun += ps;
#pragma unroll
    for (int kt = 0; kt < 2; ++kt)
#pragma unroll
      for (int s = 0; s < 2; ++s) {
        const f32x16& sx = kt ? s1 : s0;
        u32x4 pw; pw.x = pk_bf16(sx[8 * s], sx[8 * s + 1]); pw.y = pk_bf16(sx[8 * s + 2], sx[8 * s + 3]); pw.z = pk_bf16(sx[8 * s + 4], sx[8 * s + 5]); pw.w = pk_bf16(sx[8 * s + 6], sx[8 * s + 7]);
        const bf16x8 pb = __builtin_bit_cast(bf16x8, pw);
        const int ko = 32 * kt + 16 * s + 4 * hh;
        const s16x4 l0 = *(const s16x4*)(Vl + ql * AT_VROW + ko), h0 = *(const s16x4*)(Vl + ql * AT_VROW + ko + 8);
        const s16x4 l1 = *(const s16x4*)(Vl + (32 + ql) * AT_VROW + ko), h1 = *(const s16x4*)(Vl + (32 + ql) * AT_VROW + ko + 8);
        const bf16x8 av0 = __builtin_shufflevector(l0, h0, 0, 1, 2, 3, 4, 5, 6, 7), av1 = __builtin_shufflevector(l1, h1, 0, 1, 2, 3, 4, 5, 6, 7);
        o0 = MFMA32(av0, pb, o0); o1 = MFMA32(av1, pb, o1);
      }
    {
      const float mnew = fmaxf(mrun, fmaxf(mx, mxo));
      if (__builtin_amdgcn_ballot_w64(mnew > mrun) != 0ull) {
        const float alpha = __builtin_amdgcn_exp2f(mrun - mnew);
        lrun *= alpha;
#pragma unroll
        for (int i = 0; i < 16; ++i) { o0[i] *= alpha; o1[i] *= alpha; }
        mrun = mnew;
      }
    }
    if (t + 1 < nt) { bf16_t* S1 = (bf16_t*)(lds + ((t + 1) & 1) * AT_STAGE); *(u32x4*)(S1 + kn_dst) = rk; if (tid < 256) *(u32x4*)(S1 + kr_dst) = rr; *(u32x4*)(S1 + vt_dst) = rv; }
    __syncthreads();
  }
  __builtin_amdgcn_s_setprio(0);
  const float linv = 1.f / (lrun + xshfl(lrun, lane, 32));
  const int rout = pq < 256 ? NLAT + b * 256 + pq : b * 4096 + pq - 256;
  bf16_t* yo = (bf16_t*)(ows(P) + OFF_H) + (size_t)rout * 1024 + 512 + h * 64 + 4 * hh;
#pragma unroll
  for (int g4 = 0; g4 < 4; ++g4) {
    u32x2 w0, w1;
    w0.x = pk_bf16(o0[4 * g4] * linv, o0[4 * g4 + 1] * linv); w0.y = pk_bf16(o0[4 * g4 + 2] * linv, o0[4 * g4 + 3] * linv);
    w1.x = pk_bf16(o1[4 * g4] * linv, o1[4 * g4 + 1] * linv); w1.y = pk_bf16(o1[4 * g4 + 2] * linv, o1[4 * g4 + 3] * linv);
    *(u32x2*)(yo + 8 * g4) = w0; *(u32x2*)(yo + 32 + 8 * g4) = w1;
  }
}
#ifndef EN_HY
#define EN_HY 1
#endif
#ifndef EN_SG
#define EN_SG 1
#endif
#ifndef EN_AT
#define EN_AT 1
#endif
#ifndef REP_GEMM
#define REP_GEMM 1
#endif
#ifndef REP_ATTN
#define REP_ATTN 1
#endif
#ifndef REP_HY
#define REP_HY 1
#endif
#ifndef REP_P0
#define REP_P0 1
#endif
#ifndef REP_PREP
#define REP_PREP 1
#endif
#ifndef REP_SGU
#define REP_SGU 1
#endif
#ifndef REP_SYNC
#define REP_SYNC 1
#endif
#ifndef REP_UP
#define REP_UP 1
#endif
#ifndef REP_DOWN
#define REP_DOWN 1
#endif
#ifndef REP_PROJ
#define REP_PROJ 1
#endif
#ifndef REP_OUT
#define REP_OUT 1
#endif
#ifndef REP_QKV
#define REP_QKV 1
#endif
template <class Epi> DI void run_gemm(unsigned char* lds, const bf16_t* A, const bf16_t* Bt, int N, int K, const Epi& E, int wv, int M = MTOT, int reps = 1, int cshift = 0) {
  pg8::Gemm g; g.A = A; g.Bt = Bt; g.M = M; g.N = N; g.K = K;
  pg8::StaticOrder S; S.init(M, N, (int)gridDim.x, (int)((blockIdx.x + cshift) % gridDim.x)); S.ntk = K / 64;
  for (int rep = 0; rep < REP_GEMM * reps; ++rep) { Epi E2 = E; E2.wv = wv; if (rep + 1 < REP_GEMM * reps) E2.kill(); pg8::gemm_phase<Epi, pg8::StaticOrder, false>((LAS unsigned char*)lds, g, S, E2, nullptr, wv); }
}
template <class Epi> DI void run_gemm_split(unsigned char* lds, const bf16_t* A, const bf16_t* Bt, int K, int S_, const Epi& E, int wv, int reps = 1) {
  pg8::Gemm g; g.A = A; g.Bt = Bt; g.M = MTOT; g.N = 1024; g.K = K;
  pg8::SplitOrder S; S.init(K, S_, (int)gridDim.x, (int)blockIdx.x);
  for (int rep = 0; rep < REP_GEMM * reps; ++rep) { Epi E2 = E; E2.wv = wv; E2.ksub = K / S_; if (rep + 1 < REP_GEMM * reps) E2.kill(); pg8::gemm_phase<Epi, pg8::SplitOrder, false>((LAS unsigned char*)lds, g, S, E2, nullptr, wv); }
}
DI void zero_cols(const Params& P, int c0, int wv) {
  for (size_t i = (size_t)blockIdx.x * 512 + otid(wv); i < (size_t)MTOT * 32; i += (size_t)gridDim.x * 512) {
    const size_t r = i >> 5, ch = i & 31; *(u32x4*)((bf16_t*)(P.ws + OFF_H) + r * 1024 + c0 + ch * 8) = (u32x4){0, 0, 0, 0}; }
}
__global__ void __launch_bounds__(512) fwd_megakernel(Params P) {
  cg::grid_group grid = cg::this_grid();
  extern __shared__ __attribute__((aligned(16))) unsigned char lds[];
  const int wv = __builtin_amdgcn_readfirstlane(threadIdx.x >> 6);
  gchar* ws = ows(P);
  bf16_t* H = (bf16_t*)(ws + OFF_H); bf16_t* AFF = (bf16_t*)(ws + OFF_R1);
  if (blockIdx.x == 0) for (int i = threadIdx.x; i < XCD_BAR_WORDS; i += 512) ((unsigned*)(P.ws + OFF_BAR))[i] = 0u;
  if (threadIdx.x < 4) ((LAS unsigned*)((LAS unsigned char*)lds + LDS_ST_OFF))[threadIdx.x] = 0u;
  for (int rep = 0; rep < REP_P0; ++rep) phase0(P, lds, wv);
  grid.sync();
  if (threadIdx.x == 0) (void)xb_add(&((unsigned*)(P.ws + OFF_BAR))[XB_XCNT(xb_xcc_id())], 1u);
  for (int l = 0; l < 2; ++l) {
    const bf16_t* WL = (const bf16_t*)(ws + OFF_W) + (size_t)l * WL_ELEMS;
    const float* mod = (const float*)(ws + OFF_MOD) + (size_t)l * 5 * 9216;
    for (int rep = 0; rep < REP_PREP; ++rep) { if (l == 0) prep_phase<true>(P, l, 0, wv); else prep_phase<false>(P, l, 0, wv, MTOT, 8); }
    for (int rep = 0; rep < REP_SYNC; ++rep) gsync(P, lds, wv);
    { EpiSwiglu E; E.O = AFF; run_gemm(lds, H, WL + WO_UP1, 5632, 1024, E, wv, MTOT, REP_UP); }
    for (int rep = 0; rep < REP_SYNC; ++rep) gsync(P, lds, wv);
    { EpiResid E; E.xb = (bf16_t*)(ws + OFF_XB); E.xc = (float*)(ws + OFF_XC); E.part = (float*)(ws + OFF_PART); E.mod = mod + 2 * 1024; E.coef = 0.5f; run_gemm_split(lds, AFF, WL + WO_D1, DFF, 8, E, wv, REP_DOWN); }
    for (int rep = 0; rep < REP_SYNC; ++rep) gsync(P, lds, wv);
    for (int rep = 0; rep < REP_PREP; ++rep) prep_phase<false>(P, l, 3, wv, MTOT, 8);
    for (int rep = 0; rep < REP_SYNC; ++rep) gsync(P, lds, wv);
    { EpiProj E; E.ws = ws; run_gemm(lds, H, WL + WO_IN, NINP, 1024, E, wv, MTOT, REP_PROJ); }
    for (int rep = 0; rep < REP_SYNC; ++rep) gsync(P, lds, wv);
#if EN_HY
    for (int c = blockIdx.x; c < 256 * REP_HY; c += gridDim.x) hyena_item(P, l, c & 255, (LAS unsigned char*)lds, wv);
#else
    zero_cols(P, 0, wv);
#endif
    __syncthreads();
    for (int rep = 0; rep < REP_SGU; ++rep) { const MixC mc = mixprep_consts(P, l, wv);
    for (int r = blockIdx.x * 8 + wv; r < MTOT; r += gridDim.x * 16) { mixprep_row(P, l, r, wv, mc); if (r + (int)gridDim.x * 8 < MTOT) mixprep_row(P, l, r + gridDim.x * 8, wv, mc); } }
    for (int rep = 0; rep < REP_SYNC; ++rep) gsync(P, lds, wv);
#if EN_SG
    { const int nsg = l == 1 ? 256 : 272;
      for (int it = gridDim.x - 1 - blockIdx.x; it < nsg * REP_SGU; it += gridDim.x) sgu_item(P, l, it % nsg, lds, wv); }
#else
    zero_cols(P, 256, wv);
#endif
    { EpiQ E; E.ws = ws; run_gemm(lds, (const bf16_t*)(ws + OFF_CQN), WL + WO_UQ, 768, 384, E, wv, MTOT, REP_QKV); }
    { EpiKV E; E.ws = ws; run_gemm(lds, (const bf16_t*)(ws + OFF_CKVN), WL + WO_UKV, 1024, 256, E, wv, MTOT, REP_QKV, 52); }
    for (int rep = 0; rep < REP_SYNC; ++rep) gsync(P, lds, wv);
#if EN_AT
    for (int it0 = blockIdx.x; it0 < 544 * REP_ATTN; it0 += gridDim.x) { const int it = it0 % 544;
      int item;
      if (it < 512) { const int c = it & 255, k = it >> 8, xcd = c & 7, slot = c >> 3; item = (16 * k + 2 * xcd + (slot >> 4)) * 17 + 1 + (slot & 15); }
      else item = (it - 512) * 17;
      if (l == 1 && it >= 512) continue; attn_item(P, item, lds, wv); }
#else
    zero_cols(P, 512, wv); zero_cols(P, 768, wv);
#endif
    for (int rep = 0; rep < REP_SYNC; ++rep) gsync(P, lds, wv);
    { EpiResid E; E.xb = (bf16_t*)(ws + OFF_XB); E.xc = (float*)(ws + OFF_XC); E.part = (float*)(ws + OFF_PART); E.mod = mod + 5 * 1024; E.coef = 1.0f; if (l == 1) run_gemm(lds, H, WL + WO_OUT, 1024, 1024, E, wv, NLAT, REP_OUT); else run_gemm_split(lds, H, WL + WO_OUT, 1024, 4, E, wv, REP_OUT); }
    for (int rep = 0; rep < REP_SYNC; ++rep) gsync(P, lds, wv);
    for (int rep = 0; rep < REP_PREP; ++rep) prep_phase<false>(P, l, 6, wv, l == 1 ? NLAT : MTOT, l == 1 ? 0 : 4);
    for (int rep = 0; rep < REP_SYNC; ++rep) gsync(P, lds, wv);
    { EpiSwiglu E; E.O = AFF; run_gemm(lds, H, WL + WO_UP2, 5632, 1024, E, wv, l == 1 ? NLAT : MTOT); }
    for (int rep = 0; rep < REP_SYNC; ++rep) gsync(P, lds, wv);
    { EpiResid E; E.xb = (bf16_t*)(ws + OFF_XB); E.xc = (float*)(ws + OFF_XC); E.part = (float*)(ws + OFF_PART); E.mod = mod + 8 * 1024; E.coef = 0.5f; if (l == 1) run_gemm(lds, AFF, WL + WO_D2, 1024, DFF, E, wv, NLAT); else run_gemm_split(lds, AFF, WL + WO_D2, DFF, 8, E, wv); }
    for (int rep = 0; rep < REP_SYNC; ++rep) gsync(P, lds, wv);
  }
  final_phase(P, wv);
}

extern "C" void kernel_launch(void* const* d_in, const int* in_sizes, int n_in, void* d_out, int out_size, void* d_ws, size_t ws_size, hipStream_t stream) {
  constexpr size_t kDynLds = 150528;
  static int grid_blocks = 0;
  if (!grid_blocks) {
    (void)hipFuncSetAttribute((const void*)fwd_megakernel, hipFuncAttributeMaxDynamicSharedMemorySize, (int)kDynLds);
    int dev = 0, cus = 0, per_cu = 0;
    (void)hipGetDevice(&dev);
    (void)hipDeviceGetAttribute(&cus, hipDeviceAttributeMultiprocessorCount, dev);
    (void)hipOccupancyMaxActiveBlocksPerMultiprocessor(&per_cu, fwd_megakernel, 512, kDynLds);
    grid_blocks = cus > 0 ? cus : 256;
    if (ws_size < WS_END) fprintf(stderr, "workspace too small: %zu < %zu\n", ws_size, (size_t)WS_END);
  }
  Params p{};
  for (int i = 0; i < 32 && i < n_in; ++i) p.in[i] = (const float*)d_in[i];
  p.out = (float*)d_out; p.ws = (char*)d_ws;
  void* args[] = {&p};
  hipError_t e = hipLaunchCooperativeKernel((void*)fwd_megakernel, dim3(grid_blocks), dim3(512), args, kDynLds, stream);
  if (e != hipSuccess) fprintf(stderr, "cooperative launch failed: %s (grid %d)\n", hipGetErrorString(e), grid_blocks);
}
```

```cpp
#include <hip/hip_runtime.h>
#include <hip/hip_cooperative_groups.h>
#include <cstdio>
namespace cg = cooperative_groups;

#define LAS __attribute__((address_space(3)))
#define DI __device__ __forceinline__
typedef unsigned short bf16_t;
typedef short bf16x8 __attribute__((ext_vector_type(8)));
typedef short s16x4 __attribute__((ext_vector_type(4)));
typedef float f32x4 __attribute__((ext_vector_type(4)));
typedef float f32x2 __attribute__((ext_vector_type(2)));
typedef float f32x16 __attribute__((ext_vector_type(16)));
typedef unsigned u32x4 __attribute__((ext_vector_type(4)));
typedef unsigned u32x2 __attribute__((ext_vector_type(2)));
typedef __bf16 bf16x2_t __attribute__((ext_vector_type(2)));

struct Params { const float* in[32]; float* out; char* ws; };

constexpr int NLAT = 16384, MTOT = 17408, DM = 1024, DFF = 2816, NIN = 1952, NINP = 2048, NPOS = 4352;
enum { I_X = 0, I_C, I_CTX, I_CCTX, I_ADAW, I_ADAB, I_F1G, I_F1U, I_F1D, I_WIN, I_WOUT, I_HCW, I_HCB, I_HW1, I_HB1, I_HW2, I_HB2, I_HW3, I_HFREQ, I_HBIAS,
       I_SGG, I_SGB, I_SGW, I_SGBS, I_QN, I_WUQ, I_KVN, I_WUKV, I_F2G, I_F2U, I_F2D, I_FN };
constexpr size_t OFF_XC = 0;
constexpr size_t OFF_H = OFF_XC + (size_t)1024 * 1024 * 4;
constexpr size_t OFF_R1 = OFF_H + (size_t)MTOT * 1024 * 2;
constexpr size_t OFF_PROJ = OFF_R1;
constexpr size_t OFF_PT = OFF_PROJ + (size_t)MTOT * NINP * 2;
constexpr size_t OFF_PTC = OFF_PT + (size_t)4 * 768 * 4096 * 2;
constexpr size_t OFF_Q = OFF_PROJ;
constexpr size_t OFF_KN = OFF_Q + (size_t)32 * NPOS * 96 * 2;
constexpr size_t OFF_VT = OFF_KN + (size_t)32 * NPOS * 64 * 2;
constexpr size_t OFF_R2 = OFF_R1 + (size_t)MTOT * DFF * 2;
constexpr size_t OFF_PART = OFF_R2;
constexpr size_t OFF_CQN = OFF_R2;
constexpr size_t OFF_CKVN = OFF_CQN + (size_t)MTOT * 384 * 2;
constexpr size_t OFF_KR = OFF_CKVN + (size_t)MTOT * 256 * 2;
constexpr size_t OFF_UG = OFF_KR + (size_t)4 * NPOS * 32 * 2;
constexpr size_t OFF_VN = OFF_UG + (size_t)MTOT * 256 * 2;
constexpr size_t OFF_W = OFF_VN + (size_t)MTOT * 256 * 2;
constexpr size_t WO_UP1 = 0, WO_UP2 = 5767168, WO_D1 = 11534336, WO_D2 = 14417920, WO_IN = 17301504, WO_OUT = 19398656, WO_UQ = 20447232, WO_UKV = 20742144, WO_S = 21004288, WL_ELEMS = 21069824;
constexpr size_t OFF_MOD = OFF_W + 2 * WL_ELEMS * 2;
constexpr size_t OFF_H2 = OFF_MOD + (size_t)2 * 5 * 9216 * 4;
constexpr size_t OFF_H2C = OFF_H2 + (size_t)2 * 4096 * 64 * 4;
constexpr size_t OFF_TW = OFF_H2C + (size_t)2 * 256 * 64 * 4;
constexpr size_t OFF_ROPE = OFF_TW + 4096 * 8;
constexpr size_t OFF_XB = OFF_ROPE + 64 * 8 * 8;
constexpr size_t OFF_BAR = OFF_XB + (size_t)NLAT * 1024 * 2;
constexpr size_t WS_END = OFF_BAR + 16384;
static_assert(OFF_VT + (size_t)32 * NPOS * 64 * 2 <= OFF_PT, "alias overflow");
static_assert(OFF_PTC + (size_t)4 * 768 * 256 * 2 <= OFF_R2, "R1 overflow");

DI int otid(int wv) { int ln; asm volatile("v_mbcnt_lo_u32_b32 %0, -1, 0\n\tv_mbcnt_hi_u32_b32 %0, -1, %0" : "=&v"(ln)); return (wv << 6) | ln; }
DI unsigned pk_bf16(float a, float b) { f32x2 v = {a, b}; bf16x2_t r = __builtin_convertvector(v, bf16x2_t); return __builtin_bit_cast(unsigned, r); }
DI bf16_t f2bf(float a) { return (bf16_t)(pk_bf16(a, a) & 0xffffu); }
DI float bf2f(bf16_t u) { return __uint_as_float(((unsigned)u) << 16); }
DI float silu_f(float g) { return g * __builtin_amdgcn_rcpf(1.f + __expf(-g)); }
typedef __attribute__((address_space(1))) char gchar;
DI gchar* ows(const Params& P) {
  const unsigned long long w = (unsigned long long)P.ws; unsigned lo = (unsigned)w, hi = (unsigned)(w >> 32);
  asm volatile("" : "+v"(lo), "+v"(hi));
  lo = __builtin_amdgcn_readfirstlane(lo); hi = __builtin_amdgcn_readfirstlane(hi);
  return (gchar*)(((unsigned long long)hi << 32) | lo);
}
DI float rdlane_c(float v, int i) { return __builtin_bit_cast(float, __builtin_amdgcn_readlane(__builtin_bit_cast(int, v), i)); }
DI float xshfl(float v, int lane, int o) { return __builtin_bit_cast(float, __builtin_amdgcn_ds_bpermute((lane ^ o) << 2, __builtin_bit_cast(int, v))); }
#define DPP_F(v, ctrl) __builtin_bit_cast(float, __builtin_amdgcn_update_dpp(0, __builtin_bit_cast(int, (v)), (ctrl), 0xf, 0xf, true))
DI float wave_sum(float v, int lane) {
  v += DPP_F(v, 0xB1); v += DPP_F(v, 0x4E); v += DPP_F(v, 0x141); v += DPP_F(v, 0x140);
  return (rdlane_c(v, 0) + rdlane_c(v, 16)) + (rdlane_c(v, 32) + rdlane_c(v, 48));
}
DI float gelu_f(float v) {
  const float av = __builtin_fabsf(v), t = __builtin_amdgcn_rcpf(av * 0.2316418882f + 1.0f);
  float q = t * 0.5307027145f + (-0.7265760135f); q = q * t + 0.7107068705f; q = q * t + (-0.142248368f); q = q * t + 0.127414796f; q = q * t;
  const float e = __builtin_amdgcn_exp2f((v * v) * (-0.72134752044f)), m = v * (q * e);
  return v < 0.f ? m : v - m;
}
DI float rdlane(float v, int i) { return __builtin_bit_cast(float, __builtin_amdgcn_readlane(__builtin_bit_cast(int, v), i)); }
DI void row_bp(int r, int& b, int& p) { if (r < NLAT) { b = r >> 12; p = 256 + (r & 4095); } else { const int rc = r - NLAT; b = rc >> 8; p = rc & 255; } }
DI f32x4 bf4_to_f32(u32x2 w) { return (f32x4){__uint_as_float(w.x << 16), __uint_as_float(w.x & 0xffff0000u), __uint_as_float(w.y << 16), __uint_as_float(w.y & 0xffff0000u)}; }
DI u32x2 f32_to_bf4(f32x4 v) { u32x2 w; w.x = pk_bf16(v[0], v[1]); w.y = pk_bf16(v[2], v[3]); return w; }
DI f32x4 xload(const Params& P, int r, int c) {
  if (r < NLAT) return bf4_to_f32(*(const u32x2*)((const bf16_t*)(ows(P) + OFF_XB) + (size_t)r * 1024 + c));
  return *(const f32x4*)((const float*)(ows(P) + OFF_XC) + (size_t)(r - NLAT) * 1024 + c);
}
DI void xstore(const Params& P, int r, int c, f32x4 v) {
  if (r < NLAT) *(u32x2*)((bf16_t*)(ows(P) + OFF_XB) + (size_t)r * 1024 + c) = f32_to_bf4(v);
  else *(f32x4*)((float*)(ows(P) + OFF_XC) + (size_t)(r - NLAT) * 1024 + c) = v;
}

#define XB_TMO      128
#define XB_XCNT(j)  (256  + 64 * (j))
#define XB_XSUB(j)  (1280 + 64 * (j))
#define XB_XGEN(j)  (2304 + 64 * (j))
#define XB_TOP      3328
#define XB_TOPGEN   3392
#define XCD_BAR_WORDS 3456
#define XB_SPIN_CAP (1u << 20)
constexpr int LDS_ST_OFF = 133120;
constexpr int LDS_TW2_OFF = 133632;
DI unsigned xb_ld(unsigned* p) { return __hip_atomic_load(p, __ATOMIC_RELAXED, __HIP_MEMORY_SCOPE_AGENT); }
DI unsigned xb_add(unsigned* p, unsigned v) { return __hip_atomic_fetch_add(p, v, __ATOMIC_RELAXED, __HIP_MEMORY_SCOPE_AGENT); }
DI unsigned xb_xcc_id() { return (unsigned)__builtin_amdgcn_s_getreg((3 << 11) | 20) & 0xFu; }
#define XB_SPIN(cond, bar) do { unsigned _sp = 0; while (cond) { __builtin_amdgcn_s_sleep(1); \
    if ((++_sp & 255u) == 0u) { if (xb_ld(&(bar)[XB_TMO])) break; if (_sp > XB_SPIN_CAP) { atomicAdd(&(bar)[XB_TMO], 1u); break; } } } } while (0)
DI void xcd_barrier_complete(unsigned* bar, unsigned x, unsigned& nloc, unsigned& nx) {
  const unsigned G = gridDim.x;
  unsigned sum, cnt, mine, sp = 0u;
  for (;;) {
    sum = 0u; cnt = 0u; mine = 0u;
#pragma unroll
    for (unsigned j = 0; j < 16; ++j) { const unsigned c = xb_ld(&bar[XB_XCNT(j)]); sum += c; cnt += (c > 0u) ? 1u : 0u; mine = (j == x) ? c : mine; }
    if (sum == G) break;
    __builtin_amdgcn_s_sleep(1);
    if ((++sp & 255u) == 0u) { if (xb_ld(&bar[XB_TMO])) break; if (sp > XB_SPIN_CAP) { atomicAdd(&bar[XB_TMO], 1u); break; } }
  }
  nloc = mine > 0u ? mine : 1u; nx = cnt > 0u ? cnt : 1u;
}
DI void gsync(const Params& P, unsigned char* lds, int wv) {
  asm volatile("s_waitcnt vmcnt(0)" ::: "memory");
  __syncthreads();
  if (wv == 0 && __builtin_amdgcn_mbcnt_lo(~0u, 0u) == 0 && __builtin_amdgcn_mbcnt_hi(~0u, 0u) == 0) {
    unsigned* bar = (unsigned*)(ows(P) + OFF_BAR);
    volatile LAS unsigned* st = (volatile LAS unsigned*)((LAS unsigned char*)lds + LDS_ST_OFF);
    const unsigned x = xb_xcc_id();
    __builtin_amdgcn_s_waitcnt(0);
    unsigned nloc = st[0], nx = st[1];
    if (nloc == 0u) { xcd_barrier_complete(bar, x, nloc, nx); st[0] = nloc; st[1] = nx; }
    const unsigned old = xb_add(&bar[XB_XSUB(x)], 1u);
    const unsigned gen = old / nloc;
    if (old + 1u == (gen + 1u) * nloc) {
      __builtin_amdgcn_fence(__ATOMIC_RELEASE, "agent");
      asm volatile("s_waitcnt vmcnt(0)" ::: "memory");
      const unsigned og = xb_add(&bar[XB_TOP], 1u);
      const unsigned tg = og / nx;
      if (og + 1u == (tg + 1u) * nx) xb_add(&bar[XB_TOPGEN], 1u);
      else XB_SPIN(xb_ld(&bar[XB_TOPGEN]) == tg, bar);
      __builtin_amdgcn_fence(__ATOMIC_ACQUIRE, "agent");
      xb_add(&bar[XB_XGEN(x)], 1u);
      asm volatile("s_waitcnt vmcnt(0)" ::: "memory");
    } else {
      XB_SPIN(xb_ld(&bar[XB_XGEN(x)]) == gen, bar);
      __builtin_amdgcn_fence(__ATOMIC_ACQUIRE, "agent");
      asm volatile("s_waitcnt vmcnt(0)" ::: "memory");
    }
  }
  __syncthreads();
}
namespace pg8 {
#define PG8_LAS __attribute__((address_space(3)))
constexpr int BM = 256, BK = 64, HALF = 128, HTB = HALF * BK * 2  , STAGE_BYTES = 8 * HTB, NXCD = 8, WGM = 4;
__host__ __device__ __forceinline__ int lds_byte(int r, int c) { const int st = (r >> 4) * 2 + (c >> 5), rr = r & 15, cc = c & 31, ob = rr * 64 + cc * 2; return st * 1024 + (ob ^ (((ob >> 9) & 1) << 5)); }
__host__ __device__ __forceinline__ void stage_rc(int b, int& R, int& C) { const int st = b / 1024, sb = b % 1024, swz = sb ^ (((sb >> 9) & 1) << 5); R = (st >> 1) * 16 + swz / 64; C = (st & 1) * 32 + (swz % 64) / 2; }
__host__ __device__ __forceinline__ int perm32(int rho) { const int n = rho >> 4, i = rho & 15; return 8 * (i >> 2) + 4 * n + (i & 3); }

struct Unit { int pm, pn, koff, nt; };
struct Gemm { const bf16_t* A; const bf16_t* Bt; int M, N, K; };
struct StaticOrder {
    int nM, nN, nwg, G, c, ntk;
    __host__ __device__ void init(int M, int N, int G_, int c_) { nM = M / BM; nN = N / BM; nwg = nM * nN; G = G_; c = c_; }
    __host__ __device__ bool next(int i, Unit& u) const {
        const long L = (long)i * G + c; if (L >= nwg) return false;
        int wgid = (int)L; { const int q = nwg / NXCD, r = nwg % NXCD, xcd = wgid % NXCD, off = wgid / NXCD; wgid = (xcd < r ? xcd * (q + 1) : r * (q + 1) + (xcd - r) * q) + off; }
        const int nig = WGM * nN, gid = wgid / nig, fm = gid * WGM, gsz = (nM - fm) < WGM ? (nM - fm) : WGM;
        u.pm = fm + ((wgid % nig) % gsz); u.pn = (wgid % nig) / gsz; u.koff = 0; u.nt = ntk; return true;
    }
    __device__ __forceinline__ void a_ready(const Unit&) const {}
    __device__ __forceinline__ void done(const Unit&) const {}
};
struct SplitOrder {
    StaticOrder lat; int S, ksub, rounds, uneven;
    __device__ void init(int K, int S_, int G_, int c_) { lat.init(16384, 1024, G_, c_); lat.ntk = K / BK; S = S_; ksub = K / S_; rounds = (lat.nwg + G_ - 1) / G_; uneven = (K == 2816 && S_ == 8); }
    __device__ bool next(int i, Unit& u) const {
        const int nlat = lat.c < lat.nwg ? (lat.nwg - lat.c + lat.G - 1) / lat.G : 0;
        if (i < nlat) return lat.next(i, u);
        const int e = (i - nlat) * lat.G + lat.c; if (e >= 16 * S) return false;
        const int j = e / S, s = e - j * S; u.pm = 64 + (j >> 2); u.pn = j & 3;
        if (uneven) { const int q4 = s >> 2, r4 = s & 3; u.koff = (q4 * 22 + r4 * 6) * BK; u.nt = r4 == 3 ? 4 : 6; }
        else { u.koff = s * ksub; u.nt = ksub / BK; }
        return true;
    }
    __device__ __forceinline__ void a_ready(const Unit&) const {}
    __device__ __forceinline__ void done(const Unit&) const {}
};
template <class Epi, class Sched, bool STAMP = false>
__device__ __forceinline__ void gemm_phase(PG8_LAS unsigned char* lds, const Gemm g, const Sched& S, const Epi& E, unsigned long long* stamps, int wv) {
    const int tid = otid(wv), wid = __builtin_amdgcn_readfirstlane(tid >> 6), lane = tid & 63, wr = wid >> 2, wc = wid & 3, fr = lane & 15, fq = lane >> 4;
    const int K = g.K;
#define PG8_STAMP() do {} while (0)
    unsigned voffA[2], voffB[2];
#pragma unroll
    for (int i = 0; i < 2; ++i) { int R, C; stage_rc(tid * 16 + i * 8192, R, C); const int Rb = Epi::PERM ? ((R & ~31) + perm32(R & 31)) : R;
        voffA[i] = (unsigned)(R * K + C) * 2u; voffB[i] = (unsigned)(Rb * K + C) * 2u; }
    const size_t kstep = (size_t)(BK * 2);
    const size_t hstep = (size_t)HALF * K * 2;
    const size_t tstep = 2 * hstep;
    const unsigned ldsw = (unsigned)wid * 1024u;
    const int aoff = lds_byte(wr * 64 + fr, fq * 8), boff = lds_byte(wc * 32 + fr, fq * 8);
#define PG8_SA(b, h) (((b) * 2 + (h)) * HTB)
#define PG8_SB(b, h) ((4 + (b) * 2 + (h)) * HTB)
#define PG8_STAGE(bufoff, gbase, voff) do { _Pragma("unroll") for (int _i = 0; _i < 2; ++_i) \
        __builtin_amdgcn_global_load_lds((const unsigned*)((const char*)(gbase) + (voff)[_i]), (PG8_LAS unsigned*)(lds + (bufoff) + ldsw + _i * 8192), 16, 0, 0); } while (0)
#define PG8_LDA(dst, b, h) do { _Pragma("unroll") for (int m = 0; m < 4; ++m) _Pragma("unroll") for (int k = 0; k < 2; ++k) dst[m][k] = *(const PG8_LAS bf16x8*)(lds + PG8_SA(b, h) + aoff + m * 2048 + k * 1024); } while (0)
#define PG8_LDB(dst, b, h) do { _Pragma("unroll") for (int n = 0; n < 2; ++n) _Pragma("unroll") for (int k = 0; k < 2; ++k) dst[n][k] = *(const PG8_LAS bf16x8*)(lds + PG8_SB(b, h) + boff + n * 2048 + k * 1024); } while (0)
#define PG8_MMA(ai, bj, At, Bt) do { __builtin_amdgcn_s_setprio(1); _Pragma("unroll") for (int m = 0; m < 4; ++m) _Pragma("unroll") for (int n = 0; n < 2; ++n) _Pragma("unroll") for (int k = 0; k < 2; ++k) \
        acc[ai][bj][m][n] = __builtin_amdgcn_mfma_f32_16x16x32_bf16(Bt[n][k], At[m][k], acc[ai][bj][m][n], 0, 0, 0); __builtin_amdgcn_s_setprio(0); } while (0)
#define PG8_WAIT_V(n) asm volatile("s_waitcnt vmcnt(" #n ")" ::: "memory")
#define PG8_WAIT_L(n) asm volatile("s_waitcnt lgkmcnt(" #n ")" ::: "memory")
#define PG8_BAR __builtin_amdgcn_s_barrier()
#define PG8_SCHED __builtin_amdgcn_sched_barrier(0)
    Unit cur, nxt; int ui = 0;
    if (!S.next(0, cur)) return;
    f32x4 acc[2][2][4][2];
#pragma unroll
    for (int a = 0; a < 2; ++a)
#pragma unroll
        for (int b = 0; b < 2; ++b)
#pragma unroll
            for (int m = 0; m < 4; ++m)
#pragma unroll
                for (int n = 0; n < 2; ++n) acc[a][b][m][n] = (f32x4){0.f, 0.f, 0.f, 0.f};
    bf16x8 At[4][2], B0[2][2], B1[2][2];
    const char* cA = (const char*)g.A + (size_t)cur.pm * tstep + (size_t)cur.koff * 2; const char* cB = (const char*)g.Bt + (size_t)cur.pn * tstep + (size_t)cur.koff * 2;
    S.a_ready(cur);
    PG8_STAGE(PG8_SB(0, 0), cB, voffB); PG8_STAGE(PG8_SA(0, 0), cA, voffA); PG8_STAGE(PG8_SB(0, 1), cB + hstep, voffB); PG8_STAGE(PG8_SA(0, 1), cA + hstep, voffA);
    if (wr == 1) PG8_BAR;
    PG8_WAIT_V(4); PG8_BAR;
    PG8_STAGE(PG8_SB(1, 0), cB + kstep, voffB); PG8_STAGE(PG8_SA(1, 0), cA + kstep, voffA); PG8_STAGE(PG8_SB(1, 1), cB + hstep + kstep, voffB);
    PG8_WAIT_V(6); PG8_BAR;
    for (;;) {
        const bool has_next = S.next(ui + 1, nxt);
        const char* nA = has_next ? (const char*)g.A + (size_t)nxt.pm * tstep + (size_t)nxt.koff * 2 : cA; const char* nB = has_next ? (const char*)g.Bt + (size_t)nxt.pn * tstep + (size_t)nxt.koff * 2 : cB;
        const int nt = cur.nt;
        for (int t = 0; t < nt; t += 2) {
            const bool last = (t == nt - 2);
            const char* a1 = cA + (size_t)(t + 1) * kstep;
            const char* a2 = last ? nA : cA + (size_t)(t + 2) * kstep; const char* b2 = last ? nB : cB + (size_t)(t + 2) * kstep;
            const char* a3 = a2 + kstep; const char* b3 = b2 + kstep;
            if (last && has_next) S.a_ready(nxt);
            PG8_LDB(B0, 0, 0); PG8_SCHED; PG8_LDA(At, 0, 0); PG8_STAGE(PG8_SA(1, 1), a1 + hstep, voffA);
            PG8_WAIT_L(8); PG8_BAR; PG8_WAIT_L(0); PG8_MMA(0, 0, At, B0); PG8_BAR; PG8_SCHED;
            PG8_LDB(B1, 0, 1); PG8_STAGE(PG8_SB(0, 0), b2, voffB);
            PG8_BAR; PG8_WAIT_L(0); PG8_MMA(0, 1, At, B1); PG8_BAR;
            PG8_LDA(At, 0, 1); PG8_STAGE(PG8_SA(0, 0), a2, voffA);
            PG8_BAR; PG8_WAIT_L(0); PG8_MMA(1, 0, At, B0); PG8_BAR; PG8_SCHED;
            PG8_STAGE(PG8_SB(0, 1), b2 + hstep, voffB);
            PG8_WAIT_V(6); PG8_BAR; PG8_MMA(1, 1, At, B1); PG8_BAR;
            PG8_LDB(B0, 1, 0); PG8_SCHED; PG8_LDA(At, 1, 0); PG8_STAGE(PG8_SA(0, 1), a2 + hstep, voffA);
            PG8_WAIT_L(8); PG8_BAR; PG8_WAIT_L(0); PG8_MMA(0, 0, At, B0); PG8_BAR; PG8_SCHED;
            PG8_LDB(B1, 1, 1); PG8_STAGE(PG8_SB(1, 0), b3, voffB);
            PG8_BAR; PG8_WAIT_L(0); PG8_MMA(0, 1, At, B1); PG8_BAR;
            PG8_LDA(At, 1, 1); PG8_STAGE(PG8_SA(1, 0), a3, voffA);
            PG8_BAR; PG8_WAIT_L(0); PG8_MMA(1, 0, At, B0); PG8_BAR; PG8_SCHED;
            PG8_STAGE(PG8_SB(1, 1), b3 + hstep, voffB);
            PG8_WAIT_V(6); PG8_BAR; PG8_MMA(1, 1, At, B1); PG8_BAR;
        }
        if constexpr (!Epi::AFTER_DRAIN) { E(acc, cur, wr, wc, fr, fq); S.done(cur); }
        if (!has_next) break;
#pragma unroll
        for (int a = 0; a < 2; ++a)
#pragma unroll
            for (int b = 0; b < 2; ++b)
#pragma unroll
                for (int m = 0; m < 4; ++m)
#pragma unroll
                    for (int n = 0; n < 2; ++n) acc[a][b][m][n] = (f32x4){0.f, 0.f, 0.f, 0.f};
        cur = nxt; cA = nA; cB = nB; ++ui;
    }
    PG8_WAIT_V(0);
    if (wr == 0) PG8_BAR;
    PG8_BAR;
    if constexpr (Epi::AFTER_DRAIN) { E.fused(acc, cur, wr, wc, fr, fq, lds, wid, lane); S.done(cur); }
#undef PG8_STAMP
#undef PG8_SA
#undef PG8_SB
#undef PG8_STAGE
#undef PG8_LDA
#undef PG8_LDB
#undef PG8_MMA
#undef PG8_WAIT_V
#undef PG8_WAIT_L
#undef PG8_BAR
#undef PG8_SCHED
}
}
#ifndef KILL_SKIPS_EPI
#define KILL_SKIPS_EPI 0
#endif
using pg8::Unit; using pg8::HALF; using pg8::BM;
struct EpiSwiglu {
  static constexpr bool PERM = true, AFTER_DRAIN = false;
  bf16_t* O; int wv; int skip = 0;
  DI void kill() { skip = 1; }
  DI void operator()(const f32x4 (&acc)[2][2][4][2], const Unit& u, int wr, int wc, int fr_, int fq_) const {
    const int ln_ = otid(wv) & 63, fr = ln_ & 15, fq = ln_ >> 4;
    if (skip) return;
    const int row0 = u.pm * BM + wr * 64 + fr, col0 = u.pn * 128 + wc * 32 + 8 * fq;
#pragma unroll
    for (int ai = 0; ai < 2; ++ai)
#pragma unroll
      for (int m = 0; m < 4; ++m) {
        const f32x4 g0 = acc[ai][0][m][0], g1 = acc[ai][0][m][1], u0 = acc[ai][1][m][0], u1 = acc[ai][1][m][1];
        u32x4 w;
        w.x = pk_bf16(silu_f(g0[0]) * u0[0], silu_f(g0[1]) * u0[1]); w.y = pk_bf16(silu_f(g0[2]) * u0[2], silu_f(g0[3]) * u0[3]);
        w.z = pk_bf16(silu_f(g1[0]) * u1[0], silu_f(g1[1]) * u1[1]); w.w = pk_bf16(silu_f(g1[2]) * u1[2], silu_f(g1[3]) * u1[3]);
        *(u32x4*)(O + (size_t)(row0 + ai * HALF + m * 16) * DFF + col0) = w;
      }
  }
};
struct EpiResid {
  static constexpr bool PERM = false, AFTER_DRAIN = false;
  bf16_t* xb; float* xc; float* part; const float* mod;
  float coef; int wv; int skip = 0; int ksub = 0;
  DI void kill() { coef = 0.f; skip = KILL_SKIPS_EPI; }
  DI void operator()(const f32x4 (&acc)[2][2][4][2], const Unit& u, int wr, int wc, int fr_, int fq_) const {
    const int ln_ = otid(wv) & 63, fr = ln_ & 15, fq = ln_ >> 4;
    const int row0 = u.pm * BM + wr * 64 + fr, col0 = u.pn * BM + wc * 32 + 4 * fq;
    if (skip) return;
    const int bi = (u.pm < 64) ? (u.pm >> 4) : 4;
    const float* gp = mod + (size_t)bi * 9216 + col0;
    f32x4 gv[2][2];
#pragma unroll
    for (int bj = 0; bj < 2; ++bj)
#pragma unroll
      for (int n = 0; n < 2; ++n) gv[bj][n] = *(const f32x4*)(gp + bj * HALF + n * 16) * coef;
#pragma unroll
    for (int ai = 0; ai < 2; ++ai) {
      f32x4 xv[4][2][2];
      const bool lat = u.pm < 64;
#pragma unroll
      for (int m = 0; m < 4; ++m) {
        const int r = row0 + ai * HALF + m * 16;
        if (!(ksub && u.pm >= 64)) {
#pragma unroll
          for (int bj = 0; bj < 2; ++bj)
#pragma unroll
            for (int n = 0; n < 2; ++n) {
              const int c = col0 + bj * HALF + n * 16;
              xv[m][bj][n] = lat ? bf4_to_f32(*(const u32x2*)(xb + (size_t)r * 1024 + c)) : *(const f32x4*)(xc + (size_t)(r - NLAT) * 1024 + c);
            }
        }
      }
#pragma unroll
      for (int m = 0; m < 4; ++m)
#pragma unroll
        for (int bj = 0; bj < 2; ++bj)
#pragma unroll
          for (int n = 0; n < 2; ++n) {
            const int r = row0 + ai * HALF + m * 16, c = col0 + bj * HALF + n * 16;
            const f32x4 d = gv[bj][n] * acc[ai][bj][m][n];
            if (ksub && u.pm >= 64) *(f32x4*)(part + ((size_t)(u.koff / ksub) * 1024 + (r - NLAT)) * 1024 + c) = d;
            else if (lat) *(u32x2*)(xb + (size_t)r * 1024 + c) = f32_to_bf4(xv[m][bj][n] + d);
            else *(f32x4*)(xc + (size_t)(r - NLAT) * 1024 + c) = xv[m][bj][n] + d;
          }
    }
  }
};
struct EpiProj {
  static constexpr bool PERM = true, AFTER_DRAIN = false;
  gchar* ws; int wv;
  DI void kill() {}
  DI void operator()(const f32x4 (&acc)[2][2][4][2], const Unit& u, int wr, int wc, int fr_, int fq_) const {
    const int ln_ = otid(wv) & 63, fr = ln_ & 15, fq = ln_ >> 4;
    const int row0 = u.pm * BM + wr * 64 + fr, col0 = u.pn * BM + wc * 32 + 8 * fq;
    if (u.pn >= 3) {
      bf16_t* O = (bf16_t*)(ws + OFF_PROJ);
#pragma unroll
      for (int ai = 0; ai < 2; ++ai)
#pragma unroll
        for (int m = 0; m < 4; ++m)
#pragma unroll
          for (int bj = 0; bj < 2; ++bj) {
            const f32x4 v0 = acc[ai][bj][m][0], v1 = acc[ai][bj][m][1];
            u32x4 w; w.x = pk_bf16(v0[0], v0[1]); w.y = pk_bf16(v0[2], v0[3]); w.z = pk_bf16(v1[0], v1[1]); w.w = pk_bf16(v1[2], v1[3]);
            *(u32x4*)(O + (size_t)(row0 + ai * HALF + m * 16) * NINP + col0 + bj * HALF) = w;
          }
    } else {
#pragma unroll
      for (int ai = 0; ai < 2; ++ai)
#pragma unroll
        for (int m = 0; m < 4; ++m) {
          const int r = row0 + ai * HALF + m * 16;
          bf16_t* base; int ld;
          if (r < NLAT) { base = (bf16_t*)(ws + OFF_PT) + (size_t)(r >> 12) * 768 * 4096 + (r & 4095); ld = 4096; }
          else { const int rc = r - NLAT; base = (bf16_t*)(ws + OFF_PTC) + (size_t)(rc >> 8) * 768 * 256 + (rc & 255); ld = 256; }
#pragma unroll
          for (int bj = 0; bj < 2; ++bj)
#pragma unroll
            for (int n = 0; n < 2; ++n)
#pragma unroll
              for (int j = 0; j < 4; ++j) base[(size_t)(col0 + bj * HALF + 4 * n + j) * ld] = f2bf(acc[ai][bj][m][n][j]);
        }
    }
  }
};
struct EpiQ {
  static constexpr bool PERM = false, AFTER_DRAIN = false;
  gchar* ws; int wv;
  DI void kill() {}
  DI void operator()(const f32x4 (&acc)[2][2][4][2], const Unit& u, int wr, int wc, int fr_, int fq_) const {
    const int ln_ = otid(wv) & 63, fr = ln_ & 15, fq = ln_ >> 4;
    const float qs = 0.10206207261596577f * 1.4426950408889634f;
    const int row0 = u.pm * BM + wr * 64 + fr, col0 = u.pn * BM + wc * 32 + 4 * fq;
    bf16_t* Q = (bf16_t*)(ws + OFF_Q);
    const int b = u.pm < 64 ? (u.pm >> 4) : u.pm - 64, p0 = u.pm < 64 ? 256 + ((u.pm & 15) << 8) : 0;
    const f32x2* rope = (const f32x2*)(ws + OFF_ROPE);
#pragma unroll
    for (int ai = 0; ai < 2; ++ai)
#pragma unroll
      for (int m = 0; m < 4; ++m) {
        const int r = row0 + ai * HALF + m * 16, p = p0 + wr * 64 + fr + ai * HALF + m * 16;
#pragma unroll
        for (int bj = 0; bj < 2; ++bj)
#pragma unroll
          for (int n = 0; n < 2; ++n) {
            const int c = col0 + bj * HALF + n * 16, h = c / 96, d = c - h * 96;
            f32x4 v = acc[ai][bj][m][n];
            if (d >= 64 && r < NLAT) {
              const int rp = d - 64, a = rp >> 4, q0 = (rp & 15) >> 1, npos = r & 4095, coord = a ? (npos & 63) : (npos >> 6);
              const f32x2 cs0 = rope[coord * 8 + q0], cs1 = rope[coord * 8 + q0 + 1];
              const f32x4 t = v;
              v[0] = t[0] * cs0.x - t[1] * cs0.y; v[1] = t[1] * cs0.x + t[0] * cs0.y;
              v[2] = t[2] * cs1.x - t[3] * cs1.y; v[3] = t[3] * cs1.x + t[2] * cs1.y;
            }
            u32x2 w; w.x = pk_bf16(v[0] * qs, v[1] * qs); w.y = pk_bf16(v[2] * qs, v[3] * qs);
            *(u32x2*)(Q + ((size_t)(b * 8 + h) * NPOS + p) * 96 + d) = w;
          }
      }
  }
};
struct EpiKV {
  static constexpr bool PERM = false, AFTER_DRAIN = false;
  gchar* ws; int wv;
  DI void kill() {}
  DI void operator()(const f32x4 (&acc)[2][2][4][2], const Unit& u, int wr, int wc, int fr_, int fq_) const {
    const int ln_ = otid(wv) & 63, fr = ln_ & 15, fq = ln_ >> 4;
    const int row0 = u.pm * BM + wr * 64 + fr, col0 = u.pn * BM + wc * 32 + 4 * fq;
    bf16_t* KN = (bf16_t*)(ws + OFF_KN); bf16_t* VT = (bf16_t*)(ws + OFF_VT);
    const int b = u.pm < 64 ? (u.pm >> 4) : u.pm - 64, p0 = u.pm < 64 ? 256 + ((u.pm & 15) << 8) : 0;
#pragma unroll
    for (int ai = 0; ai < 2; ++ai)
#pragma unroll
      for (int m = 0; m < 4; ++m) {
        const int r = row0 + ai * HALF + m * 16, p = p0 + wr * 64 + fr + ai * HALF + m * 16;
#pragma unroll
        for (int bj = 0; bj < 2; ++bj)
#pragma unroll
          for (int n = 0; n < 2; ++n) {
            const int c = col0 + bj * HALF + n * 16, h = c >> 7, d = c & 127;
            const f32x4 v = acc[ai][bj][m][n];
            if (d < 64) { u32x2 w; w.x = pk_bf16(v[0], v[1]); w.y = pk_bf16(v[2], v[3]); *(u32x2*)(KN + ((size_t)(b * 8 + h) * NPOS + p) * 64 + d) = w; }
            else {
#pragma unroll
              for (int j = 0; j < 4; ++j) VT[((size_t)(b * 8 + h) * 64 + (d - 64 + j)) * NPOS + p] = f2bf(v[j]);
            }
          }
      }
  }
};
constexpr int WJ_ND[8] = {5632, 5632, 1024, 1024, 2048, 1024, 768, 1024};
constexpr int WJ_K[8] = {1024, 1024, 2816, 2816, 1024, 1024, 384, 256};
constexpr int WJ_T0[9] = {0, 352, 704, 880, 1056, 1184, 1248, 1266, 1282};
DI size_t wj_off(int j) { return j == 0 ? WO_UP1 : j == 1 ? WO_UP2 : j == 2 ? WO_D1 : j == 3 ? WO_D2 : j == 4 ? WO_IN : j == 5 ? WO_OUT : j == 6 ? WO_UQ : WO_UKV; }
struct WtLoad { f32x4 v[8]; int l, job, r0, k0, K; };
DI WtLoad wt_load(const Params& P, int gt, int tid) {
  WtLoad o;
  const int l = gt / 1282, lt = gt - l * 1282;
  int job = 0;
#pragma unroll
  for (int j = 1; j < 8; ++j) if (lt >= WJ_T0[j]) job = j;
  const int t = lt - WJ_T0[job], K = WJ_K[job], kt = K >> 6, r0 = (t / kt) * 256, k0 = (t % kt) * 64;
  const int tr4 = tid & 63, tk = tid >> 6, r = r0 + 4 * tr4;
  const float* base; int Ns, col = r;
  if (job < 2) { const int tt = r >> 8, bj = (r >> 7) & 1, c = r & 127; col = 128 * tt + c; Ns = DFF;
    base = P.in[job == 0 ? (bj ? I_F1U : I_F1G) : (bj ? I_F2U : I_F2G)] + (size_t)l * 1024 * DFF; }
  else if (job < 4) { base = P.in[job == 2 ? I_F1D : I_F2D] + (size_t)l * DFF * 1024; Ns = 1024; }
  else if (job == 4) { base = P.in[I_WIN] + (size_t)l * 1024 * NIN; Ns = NIN; if (r >= NIN) col = -1; }
  else if (job == 5) { base = P.in[I_WOUT] + (size_t)l * 1024 * 1024; Ns = 1024; }
  else if (job == 6) { base = P.in[I_WUQ] + (size_t)l * 384 * 768; Ns = 768; }
  else { base = P.in[I_WUKV] + (size_t)l * 256 * 1024; Ns = 1024; }
  if (job == 6) {
#pragma unroll
    for (int kk = 0; kk < 8; ++kk)
#pragma unroll
      for (int j = 0; j < 4; ++j) {
        const int rr = r + j, h = rr / 96, d = rr - h * 96; int cc = rr;
        if (d >= 64) { const int rp = d - 64, a = rp >> 4, q = (rp & 15) >> 1, pp = rp & 1; cc = h * 96 + 64 + a * 16 + pp * 8 + q; }
        o.v[kk][j] = base[(size_t)(k0 + tk * 8 + kk) * Ns + cc];
      }
  } else {
#pragma unroll
    for (int kk = 0; kk < 8; ++kk) o.v[kk] = col >= 0 ? __builtin_nontemporal_load((const f32x4*)(base + (size_t)(k0 + tk * 8 + kk) * Ns + col)) : (f32x4){0.f, 0.f, 0.f, 0.f};
  }
  o.l = l; o.job = job; o.r0 = r0; o.k0 = k0; o.K = K;
  return o;
}
DI void wt_store(const Params& P, const WtLoad& o, unsigned char* lds, int tid) {
  const int tr4 = tid & 63, tk = tid >> 6;
  bf16_t* tile = (bf16_t*)lds;
#pragma unroll
  for (int j = 0; j < 4; ++j) {
    u32x4 w; w.x = pk_bf16(o.v[0][j], o.v[1][j]); w.y = pk_bf16(o.v[2][j], o.v[3][j]); w.z = pk_bf16(o.v[4][j], o.v[5][j]); w.w = pk_bf16(o.v[6][j], o.v[7][j]);
    *(u32x4*)(tile + (4 * tr4 + j) * 72 + tk * 8) = w;
  }
  __syncthreads();
  bf16_t* dst = (bf16_t*)(ows(P) + OFF_W) + (size_t)o.l * WL_ELEMS + wj_off(o.job);
#pragma unroll
  for (int i = 0; i < 4; ++i) { const int idx = tid + 512 * i, rr = idx >> 3, ch = idx & 7;
    *(u32x4*)(dst + (size_t)(o.r0 + rr) * o.K + o.k0 + ch * 8) = *(const u32x4*)(tile + rr * 72 + ch * 8); }
  __syncthreads();
}
DI void ada_tile(const Params& P, int t, unsigned char* lds, int wv) {
  const int tid = otid(wv), l = t / 72, j0 = (t % 72) * 128, jl = tid & 31, ks = tid >> 5;
  const float* W = P.in[I_ADAW] + (size_t)l * 1024 * 9216 + j0 + 4 * jl;
  f32x4 acc[5];
#pragma unroll
  for (int bi = 0; bi < 5; ++bi) acc[bi] = (f32x4){0.f, 0.f, 0.f, 0.f};
#pragma unroll 8
  for (int k = ks * 64; k < ks * 64 + 64; ++k) {
    const f32x4 w4 = __builtin_nontemporal_load((const f32x4*)(W + (size_t)k * 9216));
#pragma unroll
    for (int bi = 0; bi < 5; ++bi) { const float cv = bi < 4 ? P.in[I_C][bi * 1024 + k] : P.in[I_CCTX][k]; acc[bi] += w4 * silu_f(cv); }
  }
  float* red = (float*)lds;
#pragma unroll
  for (int bi = 0; bi < 5; ++bi) *(f32x4*)(red + (ks * 5 + bi) * 128 + 4 * jl) = acc[bi];
  __syncthreads();
  for (int o = tid; o < 640; o += 512) {
    const int bi = o >> 7, j = o & 127; float s = 0.f;
#pragma unroll
    for (int k2 = 0; k2 < 16; ++k2) s += red[(k2 * 5 + bi) * 128 + j];
    ((float*)(ows(P) + OFF_MOD))[(size_t)(l * 5 + bi) * 9216 + j0 + j] = s + P.in[I_ADAB][l * 9216 + j0 + j];
  }
  __syncthreads();
}
DI void h2_pos(const Params& P, int idx, int wv) {
  const int lane = otid(wv) & 63;
  const int l = idx / 4352, rem = idx - l * 4352;
  const bool lat = rem < 4096; const int pos = lat ? rem : rem - 4096; const float L = lat ? 4096.f : 256.f;
  const float tn = (float)pos / (L - 1.f), w = 6.2831855f * (float)pos / L;
  float z = 0.f;
  if (lane == 0) z = tn;
  else if (lane < 33) { const int i = (lane - 1) & 15; const float band = 1e-4f + (float)i * ((15.f - 1e-4f) / 15.f), ang = w * band; z = lane < 17 ? cosf(ang) : -sinf(ang); }
  const float* w1 = P.in[I_HW1] + (size_t)l * 33 * 64; const float* w2 = P.in[I_HW2] + (size_t)l * 64 * 64;
  float h1 = P.in[I_HB1][l * 64 + lane];
#pragma unroll
  for (int i = 0; i < 33; ++i) h1 += rdlane(z, i) * w1[i * 64 + lane];
  h1 = sinf(P.in[I_HFREQ][l * 128 + lane] * h1);
  float h2 = P.in[I_HB2][l * 64 + lane];
#pragma unroll
  for (int m = 0; m < 64; ++m) h2 += rdlane(h1, m) * w2[m * 64 + lane];
  h2 = sinf(P.in[I_HFREQ][l * 128 + 64 + lane] * h2);
  float* dst = lat ? (float*)(ows(P) + OFF_H2) + ((size_t)l * 4096 + pos) * 64 : (float*)(ows(P) + OFF_H2C) + ((size_t)l * 256 + pos) * 64;
  dst[lane] = h2;
}
DI void phase0(const Params& P, unsigned char* lds, int wv) {
  const int tid = otid(wv), wave = tid >> 6, nb = gridDim.x, bid = blockIdx.x;
  for (int i = bid * 512 + tid; i < 4096 + 512 + 2 * 65536; i += nb * 512) {
    if (i < 4096) { float s, c; sincospif(-(float)i * (1.f / 4096.f), &s, &c); ((f32x2*)(ows(P) + OFF_TW))[i] = (f32x2){c, s}; }
    else if (i < 4608) { const int k = i - 4096, coord = k >> 3, q = k & 7; const float inv = 1.0f / powf(10000.f, (float)q / 8.f), ang = (float)coord * inv;
      ((f32x2*)(ows(P) + OFF_ROPE))[k] = (f32x2){cosf(ang), sinf(ang)}; }
    else { const int k = i - 4608, l = k >> 16, e = k & 65535; ((bf16_t*)(ows(P) + OFF_W))[(size_t)l * WL_ELEMS + WO_S + e] = f2bf(P.in[I_SGW][k]); }
  }
  for (int t = bid; t < 144; t += nb) ada_tile(P, t, lds, wv);
  for (int i = bid * 8 + wave; i < 8704; i += nb * 8) h2_pos(P, i, wv);
  {
    int t = bid; WtLoad cur; if (t < 2 * 1282) cur = wt_load(P, t, tid);
    while (t < 2 * 1282) { const int tn = t + nb; WtLoad nxt; if (tn < 2 * 1282) nxt = wt_load(P, tn, tid); wt_store(P, cur, lds, tid); cur = nxt; t = tn; }
  }
}
template <bool FIRST> DI void prep_phase(const Params& P, int l, int sidx, int wv, int nrows = MTOT, int nsplit = 0) {
  const int tid = otid(wv), wave = tid >> 6, lane = tid & 63;
  const float* mod = (const float*)(ows(P) + OFF_MOD) + (size_t)l * 5 * 9216;
  bf16_t* H = (bf16_t*)(ows(P) + OFF_H);
  const int stride = gridDim.x * 8;
  int r = blockIdx.x * 8 + wave;
  f32x4 v[4];
  if (r < nrows) {
    if (FIRST) { const float* src = r < NLAT ? P.in[I_X] + (size_t)r * 1024 : P.in[I_CTX] + (size_t)(r - NLAT) * 1024;
#pragma unroll
      for (int i = 0; i < 4; ++i) v[i] = __builtin_nontemporal_load((const f32x4*)(src + i * 256 + lane * 4)); }
    else {
#pragma unroll
      for (int i = 0; i < 4; ++i) v[i] = xload(P, r, i * 256 + lane * 4); }
  }
  f32x4 scc[4], shc[4]; int bic = -1;
  while (r < nrows) {
    const int rn = r + stride; f32x4 vn[4];
    if (rn < nrows) {
      if (FIRST) { const float* src = rn < NLAT ? P.in[I_X] + (size_t)rn * 1024 : P.in[I_CTX] + (size_t)(rn - NLAT) * 1024;
#pragma unroll
        for (int i = 0; i < 4; ++i) vn[i] = __builtin_nontemporal_load((const f32x4*)(src + i * 256 + lane * 4)); }
      else {
#pragma unroll
        for (int i = 0; i < 4; ++i) vn[i] = xload(P, rn, i * 256 + lane * 4); }
    }
    const int bi = r < NLAT ? (r >> 12) : 4;
    if (bi != bic) { const float* sh = mod + (size_t)bi * 9216 + sidx * 1024; const float* sc = sh + 1024; bic = bi;
#pragma unroll
      for (int i = 0; i < 4; ++i) { scc[i] = *(const f32x4*)(sc + i * 256 + lane * 4) + 1.f; shc[i] = *(const f32x4*)(sh + i * 256 + lane * 4); } }
    if (!FIRST && nsplit > 0 && r >= NLAT) {
      const float* pp = (const float*)(ows(P) + OFF_PART) + (size_t)(r - NLAT) * 1024;
      for (int s = 0; s < nsplit; ++s)
#pragma unroll
        for (int i = 0; i < 4; ++i) v[i] += *(const f32x4*)(pp + (size_t)s * 1024 * 1024 + i * 256 + lane * 4);
#pragma unroll
      for (int i = 0; i < 4; ++i) xstore(P, r, i * 256 + lane * 4, v[i]);
    }
    float ss = 0.f;
#pragma unroll
    for (int i = 0; i < 4; ++i) ss += v[i][0] * v[i][0] + v[i][1] * v[i][1] + v[i][2] * v[i][2] + v[i][3] * v[i][3];
    ss = wave_sum(ss, lane);
    const float rs = rsqrtf(ss * (1.f / 1024.f) + 1e-6f);
#pragma unroll
    for (int i = 0; i < 4; ++i) {
      const int c = i * 256 + lane * 4;
      if (FIRST) xstore(P, r, c, v[i]);
      const f32x4 o = v[i] * rs * scc[i] + shc[i];
      u32x2 w; w.x = pk_bf16(o[0], o[1]); w.y = pk_bf16(o[2], o[3]);
      *(u32x2*)(H + (size_t)r * 1024 + c) = w;
    }
#pragma unroll
    for (int i = 0; i < 4; ++i) v[i] = vn[i];
    r = rn;
  }
}
DI void final_phase(const Params& P, int wv) {
  const int tid = otid(wv), wave = tid >> 6, lane = tid & 63;
  const float* fn = P.in[I_FN];
  f32x4 fng[4];
#pragma unroll
  for (int i = 0; i < 4; ++i) fng[i] = *(const f32x4*)(fn + i * 256 + lane * 4);
  const int stride = gridDim.x * 8;
  int r = blockIdx.x * 8 + wave;
  f32x4 v[4];
  if (r < NLAT) {
#pragma unroll
    for (int i = 0; i < 4; ++i) v[i] = xload(P, r, i * 256 + lane * 4); }
  while (r < NLAT) {
    const int rn = r + stride; f32x4 vn[4];
    if (rn < NLAT) {
#pragma unroll
      for (int i = 0; i < 4; ++i) vn[i] = xload(P, rn, i * 256 + lane * 4); }
    float* X = P.out + (size_t)r * 1024;
    float ss = 0.f;
#pragma unroll
    for (int i = 0; i < 4; ++i) ss += v[i][0] * v[i][0] + v[i][1] * v[i][1] + v[i][2] * v[i][2] + v[i][3] * v[i][3];
    ss = wave_sum(ss, lane);
    const float rs = rsqrtf(ss * (1.f / 1024.f) + 1e-6f);
#pragma unroll
    for (int i = 0; i < 4; ++i) __builtin_nontemporal_store(v[i] * rs * fng[i], (f32x4*)(X + i * 256 + lane * 4));
#pragma unroll
    for (int i = 0; i < 4; ++i) v[i] = vn[i];
    r = rn;
  }
}
typedef float cpx __attribute__((ext_vector_type(2)));
#define FD DI
#define CPX_VEC 1
FD int sw(int i) { return i ^ (((i >> 5) & 7) | (((i >> 6) & 3) << 3)); }
#ifdef CPX_VEC
FD cpx cmul(cpx a, cpx b) { return a.xx * b + a.yy * cpx{-b.y, b.x}; }
FD cpx cmulc(cpx a, cpx b) { return a.xx * cpx{b.x, -b.y} + a.yy * b.yx; }
FD cpx cadd(cpx a, cpx b) { return a + b; }
FD cpx csub(cpx a, cpx b) { return a - b; }
#else
FD cpx cmul(cpx a, cpx b) { return cpx{a.x * b.x - a.y * b.y, a.x * b.y + a.y * b.x}; }
FD cpx cmulc(cpx a, cpx b) { return cpx{a.x * b.x + a.y * b.y, a.y * b.x - a.x * b.y}; }
FD cpx cadd(cpx a, cpx b) { return cpx{a.x + b.x, a.y + b.y}; }
FD cpx csub(cpx a, cpx b) { return cpx{a.x - b.x, a.y - b.y}; }
#endif
#ifdef CPX_VEC
#define C8_H(h) const float h = 0.70710678118654752f
#else
#define C8_H(h) const float h = 0.70710678118654752f
#endif
FD cpx cmul_c8(cpx a, int q) {
  if (q == 0) return a;
  if (q == 2) return cpx{a.y, -a.x};
  C8_H(h);
  if (q == 1) return cpx{(a.x + a.y) * h, (a.y - a.x) * h};
  return cpx{(a.y - a.x) * h, -(a.x + a.y) * h};
}
FD void bfly8_dif(cpx (&x)[8], cpx w1) {
  const cpx w2 = cmul(w1, w1), w4 = cmul(w2, w2);
#pragma unroll
  for (int q = 0; q < 4; ++q) { cpx a = x[q], b = x[q + 4]; x[q] = cadd(a, b); x[q + 4] = cmul(cmul_c8(csub(a, b), q), w1); }
#pragma unroll
  for (int hf = 0; hf < 8; hf += 4)
#pragma unroll
    for (int q = 0; q < 2; ++q) { cpx a = x[hf + q], b = x[hf + q + 2]; x[hf + q] = cadd(a, b); x[hf + q + 2] = cmul(cmul_c8(csub(a, b), 2 * q), w2); }
#pragma unroll
  for (int q = 0; q < 8; q += 2) { cpx a = x[q], b = x[q + 1]; x[q] = cadd(a, b); x[q + 1] = cmul(csub(a, b), w4); }
}
template <int HALF = 0, class PT, class PTW> FD void fft_r8_dif(PT W, int lg, PTW TW, int tid) {
  const int len = 1 << lg, e = len >> 3, ts = (8192 >> lg) >> HALF;
  for (int gid = tid; gid < 1024; gid += 512) {
    const int blk = gid >> (lg - 3), j = gid & (e - 1), base = (blk << lg) + j;
    cpx x[8];
#pragma unroll
    for (int q = 0; q < 8; ++q) x[q] = W[sw(base + q * e)];
    bfly8_dif(x, TW[j * ts]);
#pragma unroll
    for (int q = 0; q < 8; ++q) W[sw(base + q * e)] = x[q];
  }
}
FD cpx cmulc_c8(cpx a, int q) {
  if (q == 0) return a;
  if (q == 2) return cpx{-a.y, a.x};
  C8_H(h);
  if (q == 1) return cpx{(a.x - a.y) * h, (a.x + a.y) * h};
  return cpx{-(a.x + a.y) * h, (a.x - a.y) * h};
}
FD void bfly8_dit(cpx (&x)[8], cpx w1) {
  const cpx w2 = cmul(w1, w1), w4 = cmul(w2, w2);
#pragma unroll
  for (int q = 0; q < 8; q += 2) { cpx a = x[q], b = cmulc(x[q + 1], w4); x[q] = cadd(a, b); x[q + 1] = csub(a, b); }
#pragma unroll
  for (int hf = 0; hf < 8; hf += 4)
#pragma unroll
    for (int q = 0; q < 2; ++q) { cpx a = x[hf + q], b = cmulc_c8(cmulc(x[hf + q + 2], w2), 2 * q); x[hf + q] = cadd(a, b); x[hf + q + 2] = csub(a, b); }
#pragma unroll
  for (int q = 0; q < 4; ++q) { cpx a = x[q], b = cmulc_c8(cmulc(x[q + 4], w1), q); x[q] = cadd(a, b); x[q + 4] = csub(a, b); }
}
template <int HALF = 0, class PT, class PTW> FD void ifft_r8_dit(PT W, int lg, PTW TW, int tid) {
  const int len = 1 << lg, e = len >> 3, ts = (8192 >> lg) >> HALF;
  for (int gid = tid; gid < 1024; gid += 512) {
    const int blk = gid >> (lg - 3), j = gid & (e - 1), base = (blk << lg) + j;
    cpx x[8];
#pragma unroll
    for (int q = 0; q < 8; ++q) x[q] = W[sw(base + q * e)];
    bfly8_dit(x, TW[j * ts]);
#pragma unroll
    for (int q = 0; q < 8; ++q) W[sw(base + q * e)] = x[q];
  }
}
template <class PT> FD void fft_r2_first(PT W, const cpx* TW, int tid) {
  for (int i = tid; i < 4096; i += 512) { cpx a = W[sw(i)], b = W[sw(i + 4096)]; W[sw(i)] = cadd(a, b); W[sw(i + 4096)] = cmul(csub(a, b), TW[i]); }
}
FD int brev13(int x) {
  unsigned v = (unsigned)x; v = ((v >> 1) & 0x55555555u) | ((v & 0x55555555u) << 1); v = ((v >> 2) & 0x33333333u) | ((v & 0x33333333u) << 2);
  v = ((v >> 4) & 0x0F0F0F0Fu) | ((v & 0x0F0F0F0Fu) << 4); v = ((v >> 8) & 0x00FF00FFu) | ((v & 0x00FF00FFu) << 8); v = (v >> 16) | (v << 16); return (int)(v >> 19);
}
template <class PT, class PF> FD void spec_mul(PT W, PF F, int o, int tid) {
  for (int pos = tid; pos < 8192; pos += 512) {
    const int k = brev13(pos), kn = (8192 - k) & 8191, posn = brev13(kn);
    const cpx Z = F[sw(pos)], Zn = F[sw(posn)];
    cpx kf;
    if (o == 0) kf = cpx{0.5f * (Z.x + Zn.x), 0.5f * (Z.y - Zn.y)};
    else        kf = cpx{0.5f * (Z.y + Zn.y), -0.5f * (Z.x - Zn.x)};
    W[sw(pos)] = cmul(W[sw(pos)], kf);
  }
}
#define MFMA32(a, b, c) __builtin_amdgcn_mfma_f32_32x32x16_bf16((a), (b), (c), 0, 0, 0)
struct MixC { float qn[6], kvn[4]; f32x4 g4, b4; };
DI MixC mixprep_consts(const Params& P, int l, int wv) {
  const int lane = otid(wv) & 63; MixC c;
#pragma unroll
  for (int i = 0; i < 6; ++i) c.qn[i] = P.in[I_QN][l * 384 + lane + 64 * i];
#pragma unroll
  for (int i = 0; i < 4; ++i) c.kvn[i] = P.in[I_KVN][l * 256 + lane + 64 * i];
  c.g4 = *(const f32x4*)(P.in[I_SGG] + l * 256 + 4 * lane); c.b4 = *(const f32x4*)(P.in[I_SGB] + l * 256 + 4 * lane);
  return c;
}
DI void mixprep_row(const Params& P, int l, int r, int wv, const MixC& C) {
  const int lane = otid(wv) & 63;
  const bf16_t* pr = (const bf16_t*)(ows(P) + OFF_PROJ) + (size_t)r * NINP;
  float q[6], k[4];
#pragma unroll
  for (int i = 0; i < 6; ++i) q[i] = bf2f(pr[1280 + lane + 64 * i]);
#pragma unroll
  for (int i = 0; i < 4; ++i) k[i] = bf2f(pr[1664 + lane + 64 * i]);
  const u32x2 ru = *(const u32x2*)(pr + 768 + 4 * lane), rv2 = *(const u32x2*)(pr + 1024 + 4 * lane);
  const int a = (lane >> 4) & 1, qq = (lane & 15) >> 1, pp = lane & 1;
  const float xs = bf2f(pr[1920 + a * 16 + pp * 8 + qq]), xp = bf2f(pr[1920 + a * 16 + (1 - pp) * 8 + qq]);
  f32x2 cs = {1.f, 0.f};
  if (r < NLAT) { const int npos = r & 4095, coord = a ? (npos & 63) : (npos >> 6); cs = ((const f32x2*)(ows(P) + OFF_ROPE))[coord * 8 + qq]; }
  float ss = 0.f;
#pragma unroll
  for (int i = 0; i < 6; ++i) ss += q[i] * q[i];
  ss = wave_sum(ss, lane);
  float rs = rsqrtf(ss * (1.f / 384.f) + 1e-6f);
  bf16_t* cq = (bf16_t*)(ows(P) + OFF_CQN) + (size_t)r * 384;
#pragma unroll
  for (int i = 0; i < 6; ++i) cq[lane + 64 * i] = f2bf(q[i] * rs * C.qn[i]);
  ss = 0.f;
#pragma unroll
  for (int i = 0; i < 4; ++i) ss += k[i] * k[i];
  ss = wave_sum(ss, lane);
  rs = rsqrtf(ss * (1.f / 256.f) + 1e-6f);
  bf16_t* ck = (bf16_t*)(ows(P) + OFF_CKVN) + (size_t)r * 256;
#pragma unroll
  for (int i = 0; i < 4; ++i) ck[lane + 64 * i] = f2bf(k[i] * rs * C.kvn[i]);
  {
    const float u0 = gelu_f(__uint_as_float(ru.x << 16)), u1 = gelu_f(__uint_as_float(ru.x & 0xffff0000u)), u2 = gelu_f(__uint_as_float(ru.y << 16)), u3 = gelu_f(__uint_as_float(ru.y & 0xffff0000u));
    float v[4] = {gelu_f(__uint_as_float(rv2.x << 16)), gelu_f(__uint_as_float(rv2.x & 0xffff0000u)), gelu_f(__uint_as_float(rv2.y << 16)), gelu_f(__uint_as_float(rv2.y & 0xffff0000u))};
    const float mu = wave_sum(v[0] + v[1] + v[2] + v[3], lane) * (1.f / 256.f);
    float d2 = 0.f;
#pragma unroll
    for (int j = 0; j < 4; ++j) { v[j] -= mu; d2 += v[j] * v[j]; }
    const float rs2 = rsqrtf(wave_sum(d2, lane) * (1.f / 256.f) + 1e-6f);
    u32x2 wu, wv2; wu.x = pk_bf16(u0, u1); wu.y = pk_bf16(u2, u3);
    wv2.x = pk_bf16(v[0] * rs2 * C.g4[0] + C.b4[0], v[1] * rs2 * C.g4[1] + C.b4[1]); wv2.y = pk_bf16(v[2] * rs2 * C.g4[2] + C.b4[2], v[3] * rs2 * C.g4[3] + C.b4[3]);
    *(u32x2*)((bf16_t*)(ows(P) + OFF_UG) + (size_t)r * 256 + 4 * lane) = wu;
    *(u32x2*)((bf16_t*)(ows(P) + OFF_VN) + (size_t)r * 256 + 4 * lane) = wv2;
  }
  if (lane < 32) {
    const float o = r < NLAT ? (pp ? xs * cs.x + xp * cs.y : xs * cs.x - xp * cs.y) : xs;
    int b, p; row_bp(r, b, p);
    ((bf16_t*)(ows(P) + OFF_KR))[((size_t)b * NPOS + p) * 32 + lane] = f2bf(o);
  }
}
DI void sgu_item(const Params& P, int l, int item, unsigned char* lds, int wv) {
  const int tid = otid(wv), wave = tid >> 6, lane = tid & 63, ci = item >> 1, gp = item & 1, r0 = ci * 128;
  const bf16_t* VN = (const bf16_t*)(ows(P) + OFF_VN); const bf16_t* UG = (const bf16_t*)(ows(P) + OFF_UG);
  bf16_t* vT = (bf16_t*)lds;
#pragma unroll
  for (int i = 0; i < 4; ++i) {
    const int e = tid + 512 * i, q = e >> 4, c8 = (e & 15) * 8;
    const u32x4 raw = *(const u32x4*)(VN + (size_t)(r0 + q) * 256 + gp * 128 + c8);
    const unsigned w[4] = {raw.x, raw.y, raw.z, raw.w};
#pragma unroll
    for (int j = 0; j < 4; ++j) { vT[(c8 + 2 * j) * 136 + q] = (bf16_t)(w[j] & 0xffffu); vT[(c8 + 2 * j + 1) * 136 + q] = (bf16_t)(w[j] >> 16); }
  }
  __syncthreads();
  const int ql = lane & 31, hh = lane >> 5, gl = wave >> 2, g = 2 * gp + gl, chl = gl * 64 + (wave & 1) * 32 + ql, pt0 = ((wave >> 1) & 1) * 2;
  const bf16_t* Ws = (const bf16_t*)(ows(P) + OFF_W) + (size_t)l * WL_ELEMS + WO_S + (size_t)g * 128 * 128;
  f32x16 acc[2];
#pragma unroll
  for (int pt = 0; pt < 2; ++pt)
#pragma unroll
    for (int i = 0; i < 16; ++i) acc[pt][i] = 0.f;
#pragma unroll
  for (int s = 0; s < 8; ++s) {
    const bf16x8 bfr = *(const bf16x8*)(vT + chl * 136 + 16 * s + 8 * hh);
#pragma unroll
    for (int pt = 0; pt < 2; ++pt) {
      const bf16x8 afr = *(const bf16x8*)(Ws + (size_t)(32 * (pt0 + pt) + ql) * 128 + 16 * s + 8 * hh);
      acc[pt] = MFMA32(afr, bfr, acc[pt]);
    }
  }
  bf16_t* YC = (bf16_t*)(ows(P) + OFF_H);
  const float* bs = P.in[I_SGBS] + (size_t)l * 512 + g * 128;
  const int chg = gp * 128 + chl;
#pragma unroll
  for (int pt = 0; pt < 2; ++pt)
#pragma unroll
    for (int i = 0; i < 16; ++i) {
      const int p = 32 * (pt0 + pt) + (i & 3) + 8 * (i >> 2) + 4 * hh;
      const float u = bf2f(UG[(size_t)(r0 + p) * 256 + chg]);
      YC[(size_t)(r0 + p) * 1024 + 256 + chg] = f2bf(u * (acc[pt][i] + bs[p]));
    }
  __syncthreads();
}
DI float sconv(const bf16_t* p, int t, int L, float w0, float w1, float w2, float bb) {
  const float a = t > 0 ? bf2f(p[t - 1]) : 0.f, b = bf2f(p[t]), c = t < L - 1 ? bf2f(p[t + 1]) : 0.f;
  return w0 * a + w1 * b + w2 * c + bb;
}
DI void hyena_item(const Params& P, int l, int c, LAS unsigned char* lds, int wv) {
  const int tid = otid(wv);
  LAS cpx* W = (LAS cpx*)lds; LAS cpx* F = W + 8192; LAS float* w3s = (LAS float*)(F + 8192);
  LAS cpx* TW2 = (LAS cpx*)(lds + LDS_TW2_OFF);
  asm volatile("" : "+v"(F), "+v"(w3s), "+v"(TW2));
  const cpx* TW = (const cpx*)(ows(P) + OFF_TW);
#pragma unroll
  for (int i = 0; i < 4; ++i) TW2[tid + 512 * i] = TW[2 * (tid + 512 * i)];
  if (tid < 256) w3s[tid] = P.in[I_HW3][(size_t)l * 64 * 1024 + (tid & 63) * 1024 + (tid >> 6) * 256 + c];
  const float delta = 3.0701134573f + (float)c * ((15.350567286f - 3.0701134573f) / 255.f);
  const float* cwp = P.in[I_HCW] + (size_t)l * 3 * 768; const float* cbp = P.in[I_HCB] + (size_t)l * 768;
  float cw[3][3], cb[3];
#pragma unroll
  for (int k = 0; k < 3; ++k) { cb[k] = cbp[k * 256 + c];
#pragma unroll
    for (int j = 0; j < 3; ++j) cw[k][j] = cwp[j * 768 + k * 256 + c]; }
  const float bias0 = P.in[I_HBIAS][l * 512 + c], bias1 = P.in[I_HBIAS][l * 512 + 256 + c];
  bf16_t* YC = (bf16_t*)(ows(P) + OFF_H);
  __syncthreads();
#ifndef HYP_A
#define HYP_A 1
#endif
#ifndef HYP_B
#define HYP_B 1
#endif
#ifndef HYP_C
#define HYP_C 1
#endif
  for (int repa = 0; repa < HYP_A; ++repa)
  if (l == 0) {
    LAS float* kc = (LAS float*)W; LAS float* vb = kc + 1024; LAS float* v1b = vb + 1024;
    const float* H2C = (const float*)(ows(P) + OFF_H2C) + (size_t)l * 256 * 64;
    if (tid < 256) {
      const int t = tid; float d[4] = {0.f, 0.f, 0.f, 0.f};
      f32x4 hrow[16];
#pragma unroll
      for (int m4 = 0; m4 < 16; ++m4) hrow[m4] = *(const f32x4*)(H2C + t * 64 + 4 * m4);
#pragma unroll
      for (int m4 = 0; m4 < 16; ++m4)
#pragma unroll
        for (int od = 0; od < 4; ++od) { const f32x4 w = *(LAS const f32x4*)(w3s + od * 64 + 4 * m4); d[od] += hrow[m4][0] * w[0] + hrow[m4][1] * w[1] + hrow[m4][2] * w[2] + hrow[m4][3] * w[3]; }
      const float win = __expf(-((float)t / 255.f) * delta) + 0.05f;
      if (t == 0) { kc[255] = (d[0] + d[1]) * win; kc[512 + 255] = (d[2] + d[3]) * win; }
      else { kc[255 + t] = d[0] * win; kc[255 - t] = d[1] * win; kc[512 + 255 + t] = d[2] * win; kc[512 + 255 - t] = d[3] * win; }
    }
    const int cb_ = (tid >> 6) & 3, t0 = (tid & 63) * 4;
    const bf16_t* pbc = (const bf16_t*)(ows(P) + OFF_PTC) + (size_t)cb_ * 768 * 256;
    float x1r[4], x2r[4], vr[4], v1r[4];
    if (tid < 256) {
#pragma unroll
      for (int i = 0; i < 4; ++i) {
        x1r[i] = sconv(pbc + (size_t)c * 256, t0 + i, 256, cw[0][0], cw[0][1], cw[0][2], cb[0]);
        x2r[i] = sconv(pbc + (size_t)(256 + c) * 256, t0 + i, 256, cw[1][0], cw[1][1], cw[1][2], cb[1]);
        vr[i] = sconv(pbc + (size_t)(512 + c) * 256, t0 + i, 256, cw[2][0], cw[2][1], cw[2][2], cb[2]);
        vb[cb_ * 256 + t0 + i] = vr[i];
      }
    }
    __syncthreads();
#pragma unroll
    for (int o = 0; o < 2; ++o) {
      if (tid < 256) {
        LAS const float* src = o ? v1b : vb; LAS const float* kk = kc + o * 512 + 255 + t0;
        float y[4] = {0.f, 0.f, 0.f, 0.f};
        for (int s4 = 0; s4 < 64; ++s4) {
          const f32x4 u4 = *(LAS const f32x4*)(src + cb_ * 256 + 4 * s4);
          float kv[7];
#pragma unroll
          for (int j = 0; j < 7; ++j) kv[j] = kk[j - 3 - 4 * s4];
#pragma unroll
          for (int i = 0; i < 4; ++i)
#pragma unroll
            for (int j = 0; j < 4; ++j) y[i] += kv[3 + i - j] * u4[j];
        }
        if (o == 0) {
#pragma unroll
          for (int i = 0; i < 4; ++i) { v1r[i] = x1r[i] * (y[i] + vr[i] * bias0); v1b[cb_ * 256 + t0 + i] = v1r[i]; }
        } else {
#pragma unroll
          for (int i = 0; i < 4; ++i) YC[(size_t)(NLAT + cb_ * 256 + t0 + i) * 1024 + c] = f2bf(x2r[i] * (y[i] + v1r[i] * bias1));
        }
      }
      __syncthreads();
    }
  }
  for (int repb = 0; repb < HYP_B; ++repb)
  {
    const float* H2 = (const float*)(ows(P) + OFF_H2) + (size_t)l * 4096 * 64;
    LAS float* tile = (LAS float*)W; LAS float* Ff = (LAS float*)F;
    const int tl = tid & 127, od = tid >> 7;
    if (tid < 2) { float z0 = 0.f; asm volatile("" : "+v"(z0)); F[sw(tid * 4096)] = cpx{z0, z0}; }
    f32x4 w4[16];
#pragma unroll
    for (int m4 = 0; m4 < 16; ++m4) w4[m4] = *(LAS const f32x4*)(w3s + od * 64 + 4 * m4);
    f32x4 stg[4];
#pragma unroll
    for (int i = 0; i < 4; ++i) { const int e = tid + 512 * i; stg[i] = *(const f32x4*)(H2 + (size_t)(e >> 4) * 64 + 4 * (e & 15)); }
#pragma unroll 1
    for (int t0 = 0; t0 < 4096; t0 += 128) {
#pragma unroll
      for (int i = 0; i < 4; ++i) { const int e = tid + 512 * i, row = e >> 4, c4 = e & 15; *(LAS f32x4*)(tile + row * 68 + 4 * c4) = stg[i]; }
      if (t0 + 128 < 4096) {
#pragma unroll
        for (int i = 0; i < 4; ++i) { const int e = tid + 512 * i; stg[i] = *(const f32x4*)(H2 + (size_t)(t0 + 128 + (e >> 4)) * 64 + 4 * (e & 15)); }
      }
      __syncthreads();
      float d = 0.f;
#pragma unroll
      for (int m4 = 0; m4 < 16; ++m4) { const f32x4 hv = *(LAS const f32x4*)(tile + tl * 68 + 4 * m4); d += hv[0] * w4[m4][0] + hv[1] * w4[m4][1] + hv[2] * w4[m4][2] + hv[3] * w4[m4][3]; }
      const int t = t0 + tl;
      d *= __expf(-((float)t / 4095.f) * delta) + 0.05f;
      if (t == 0) atomicAdd((float*)(Ff + 2 * sw(0) + (od >> 1)), d);
      else Ff[2 * sw((od & 1) ? 8192 - t : t) + (od >> 1)] = d;
      __syncthreads();
    }
    __syncthreads();
    fft_r2_first(F, TW, tid); __syncthreads();
    fft_r8_dif<1>(F, 12, TW2, tid); __syncthreads(); fft_r8_dif<1>(F, 9, TW2, tid); __syncthreads(); fft_r8_dif<1>(F, 6, TW2, tid); __syncthreads(); fft_r8_dif<1>(F, 3, TW2, tid); __syncthreads();
  }
  for (int bp_ = 0; bp_ < 2 * HYP_C; ++bp_) { const int bp = bp_ & 1;
    float v[8][2];
    const bf16_t* pb0 = (const bf16_t*)(ows(P) + OFF_PT) + (size_t)(2 * bp) * 768 * 4096; const bf16_t* pb1 = pb0 + (size_t)768 * 4096;
#pragma unroll
    for (int i = 0; i < 8; ++i) {
      const int t = tid + 512 * i;
      v[i][0] = sconv(pb0 + (size_t)(512 + c) * 4096, t, 4096, cw[2][0], cw[2][1], cw[2][2], cb[2]);
      v[i][1] = sconv(pb1 + (size_t)(512 + c) * 4096, t, 4096, cw[2][0], cw[2][1], cw[2][2], cb[2]);
    }
#pragma unroll
    for (int o = 0; o < 2; ++o) {
      float gt[8][2];
#pragma unroll
      for (int i = 0; i < 8; ++i) {
        const int t = tid + 512 * i;
        gt[i][0] = sconv(pb0 + (size_t)(o * 256 + c) * 4096, t, 4096, cw[o][0], cw[o][1], cw[o][2], cb[o]);
        gt[i][1] = sconv(pb1 + (size_t)(o * 256 + c) * 4096, t, 4096, cw[o][0], cw[o][1], cw[o][2], cb[o]);
      }
      int t2 = tid; asm volatile("" : "+v"(t2));
      const cpx w12 = TW2[t2];
      {
        cpx lo[8];
#pragma unroll
        for (int q = 0; q < 8; ++q) lo[q] = cpx{v[q][0], v[q][1]};
        bfly8_dif(lo, w12);
#pragma unroll
        for (int q = 0; q < 8; ++q) W[sw(tid + 512 * q)] = lo[q];
        __builtin_amdgcn_sched_barrier(0);
#pragma unroll
        for (int q = 0; q < 8; ++q) lo[q] = cmul(cpx{v[q][0], v[q][1]}, TW[t2 + 512 * q]);
        bfly8_dif(lo, w12);
#pragma unroll
        for (int q = 0; q < 8; ++q) W[sw(4096 + tid + 512 * q)] = lo[q];
      }
      __syncthreads();
      fft_r8_dif<1>(W, 9, TW2, tid); __syncthreads(); fft_r8_dif<1>(W, 6, TW2, tid); __syncthreads(); fft_r8_dif<1>(W, 3, TW2, tid); __syncthreads();
      spec_mul(W, F, o, tid); __syncthreads();
      ifft_r8_dit<1>(W, 3, TW2, tid); __syncthreads(); ifft_r8_dit<1>(W, 6, TW2, tid); __syncthreads(); ifft_r8_dit<1>(W, 9, TW2, tid); __syncthreads();
      const float bo = o ? bias1 : bias0;
      cpx rlo[8], rup[8];
#pragma unroll
      for (int q = 0; q < 8; ++q) rlo[q] = W[sw(tid + 512 * q)];
      bfly8_dit(rlo, w12);
      __builtin_amdgcn_sched_barrier(0);
#pragma unroll
      for (int q = 0; q < 8; ++q) rup[q] = W[sw(4096 + tid + 512 * q)];
      bfly8_dit(rup, w12);
      int tq = tid; asm volatile("" : "+v"(tq));
#pragma unroll
      for (int i = 0; i < 8; ++i) {
        const int t = tid + 512 * i;
        cpx r = cadd(rlo[i], cmulc(rup[i], TW[tq + 512 * i])); r.x *= (1.f / 8192.f); r.y *= (1.f / 8192.f);
        const float g0 = gt[i][0], g1 = gt[i][1];
        if (o == 0) { v[i][0] = g0 * (r.x + v[i][0] * bo); v[i][1] = g1 * (r.y + v[i][1] * bo); }
        else {
          YC[(size_t)((2 * bp) * 4096 + t) * 1024 + c] = f2bf(g0 * (r.x + v[i][0] * bo));
          YC[(size_t)((2 * bp + 1) * 4096 + t) * 1024 + c] = f2bf(g1 * (r.y + v[i][1] * bo));
        }
      }
      __syncthreads();
#ifdef HYP_FFT
      for (int rp = 0; rp < HYP_FFT; ++rp) {
        fft_r8_dif<1>(W, 12, TW2, tid); __syncthreads(); fft_r8_dif<1>(W, 9, TW2, tid); __syncthreads(); fft_r8_dif<1>(W, 6, TW2, tid); __syncthreads(); fft_r8_dif<1>(W, 3, TW2, tid); __syncthreads();
        ifft_r8_dit<1>(W, 3, TW2, tid); __syncthreads(); ifft_r8_dit<1>(W, 6, TW2, tid); __syncthreads(); ifft_r8_dit<1>(W, 9, TW2, tid); __syncthreads(); ifft_r8_dit<1>(W, 12, TW2, tid); __syncthreads();
      }
#endif
    }
  }
}
constexpr int AT_KROW = 104, AT_VROW = 72, AT_STAGE = (64 * AT_KROW + 64 * AT_VROW) * 2;
DI void attn_item(const Params& P, int item, unsigned char* lds, int wv) {
  const int tid = otid(wv), wave = tid >> 6, lane = tid & 63, ql = lane & 31, hh = lane >> 5;
  const int qb = item % 17, bh = item / 17, b = bh >> 3, h = bh & 7;
  const int nt = qb == 0 ? 4 : 68;
  const int pq = qb * 256 + wave * 32 + ql;
  const bf16_t* qptr = (const bf16_t*)(ows(P) + OFF_Q) + ((size_t)bh * NPOS + pq) * 96 + 8 * hh;
  bf16x8 qf[6];
#pragma unroll
  for (int s = 0; s < 6; ++s) qf[s] = *(const bf16x8*)(qptr + 16 * s);
  const bf16_t* kn_src = (const bf16_t*)(ows(P) + OFF_KN) + ((size_t)bh * NPOS + (tid >> 3)) * 64 + (tid & 7) * 8;
  const bf16_t* kr_src = (const bf16_t*)(ows(P) + OFF_KR) + ((size_t)b * NPOS + ((tid & 255) >> 2)) * 32 + (tid & 3) * 8;
  const bf16_t* vt_src = (const bf16_t*)(ows(P) + OFF_VT) + ((size_t)bh * 64 + (tid >> 3)) * NPOS + (tid & 7) * 8;
  const int kn_dst = (tid >> 3) * AT_KROW + (tid & 7) * 8, kr_dst = ((tid & 255) >> 2) * AT_KROW + 64 + (tid & 3) * 8, vt_dst = 64 * AT_KROW + (tid >> 3) * AT_VROW + (tid & 7) * 8;
  u32x4 rk, rr = {0, 0, 0, 0}, rv;
  rk = *(const u32x4*)kn_src; if (tid < 256) rr = *(const u32x4*)kr_src; rv = *(const u32x4*)vt_src;
  { bf16_t* S0 = (bf16_t*)lds; *(u32x4*)(S0 + kn_dst) = rk; if (tid < 256) *(u32x4*)(S0 + kr_dst) = rr; *(u32x4*)(S0 + vt_dst) = rv; }
  __syncthreads();
  f32x16 o0, o1;
#pragma unroll
  for (int i = 0; i < 16; ++i) { o0[i] = 0.f; o1[i] = 0.f; }
  float mrun = -1e30f, lrun = 0.f;
  for (int t = 0; t < nt; ++t) {
    if (t + 1 < nt) { rk = *(const u32x4*)(kn_src + (size_t)(t + 1) * 64 * 64); if (tid < 256) rr = *(const u32x4*)(kr_src + (size_t)(t + 1) * 64 * 32); rv = *(const u32x4*)(vt_src + (t + 1) * 64); }
    const bf16_t* Kl = (const bf16_t*)(lds + (t & 1) * AT_STAGE); const bf16_t* Vl = Kl + 64 * AT_KROW;
    f32x16 s0, s1;
#pragma unroll
    for (int i = 0; i < 16; ++i) { s0[i] = 0.f; s1[i] = 0.f; }
#pragma unroll
    for (int s = 0; s < 6; ++s) {
      const bf16x8 a0 = *(const bf16x8*)(Kl + ql * AT_KROW + 16 * s + 8 * hh), a1 = *(const bf16x8*)(Kl + (32 + ql) * AT_KROW + 16 * s + 8 * hh);
      s0 = MFMA32(a0, qf[s], s0); s1 = MFMA32(a1, qf[s], s1);
    }
    float mx = s0[0];
#pragma unroll
    for (int i = 0; i < 16; ++i) mx = fmaxf(mx, fmaxf(s0[i], s1[i]));
    const float mxo = xshfl(mx, lane, 32);
    if (t == 0) mrun = fmaxf(mx, mxo);
    float ps = 0.f;
#pragma unroll
    for (int i = 0; i < 16; ++i) { s0[i] = __builtin_amdgcn_exp2f(s0[i] - mrun); s1[i] = __builtin_amdgcn_exp2f(s1[i] - mrun); ps += s0[i] + s1[i]; }
    lrun += ps;
#pragma unroll
    for (int kt = 0; kt < 2; ++kt)
#pragma unroll
      for (int s = 0; s < 2; ++s) {
        const f32x16& sx = kt ? s1 : s0;
        u32x4 pw; pw.x = pk_bf16(sx[8 * s], sx[8 * s + 1]); pw.y = pk_bf16(sx[8 * s + 2], sx[8 * s + 3]); pw.z = pk_bf16(sx[8 * s + 4], sx[8 * s + 5]); pw.w = pk_bf16(sx[8 * s + 6], sx[8 * s + 7]);
        const bf16x8 pb = __builtin_bit_cast(bf16x8, pw);
        const int ko = 32 * kt + 16 * s + 4 * hh;
        const s16x4 l0 = *(const s16x4*)(Vl + ql * AT_VROW + ko), h0 = *(const s16x4*)(Vl + ql * AT_VROW + ko + 8);
        const s16x4 l1 = *(const s16x4*)(Vl + (32 + ql) * AT_VROW + ko), h1 = *(const s16x4*)(Vl + (32 + ql) * AT_VROW + ko + 8);
        const bf16x8 av0 = __builtin_shufflevector(l0, h0, 0, 1, 2, 3, 4, 5, 6, 7), av1 = __builtin_shufflevector(l1, h1, 0, 1, 2, 3, 4, 5, 6, 7);
        o0 = MFMA32(av0, pb, o0); o1 = MFMA32(av1, pb, o1);
      }
    {
      const float mnew = fmaxf(mrun, fmaxf(mx, mxo));
      if (__builtin_amdgcn_ballot_w64(mnew > mrun) != 0ull) {
        const float alpha = __builtin_amdgcn_exp2f(mrun - mnew);
        lrun *= alpha;
#pragma unroll
        for (int i = 0; i < 16; ++i) { o0[i] *= alpha; o1[i] *= alpha; }
        mrun = mnew;
      }
    }
    if (t + 1 < nt) { bf16_t* S1 = (bf16_t*)(lds + ((t + 1) & 1) * AT_STAGE); *(u32x4*)(S1 + kn_dst) = rk; if (tid < 256) *(u32x4*)(S1 + kr_dst) = rr; *(u32x4*)(S1 + vt_dst) = rv; }
    __syncthreads();
  }
  const float linv = 1.f / (lrun + xshfl(lrun, lane, 32));
  const int rout = pq < 256 ? NLAT + b * 256 + pq : b * 4096 + pq - 256;
  bf16_t* yo = (bf16_t*)(ows(P) + OFF_H) + (size_t)rout * 1024 + 512 + h * 64 + 4 * hh;
#pragma unroll
  for (int g4 = 0; g4 < 4; ++g4) {
    u32x2 w0, w1;
    w0.x = pk_bf16(o0[4 * g4] * linv, o0[4 * g4 + 1] * linv); w0.y = pk_bf16(o0[4 * g4 + 2] * linv, o0[4 * g4 + 3] * linv);
    w1.x = pk_bf16(o1[4 * g4] * linv, o1[4 * g4 + 1] * linv); w1.y = pk_bf16(o1[4 * g4 + 2] * linv, o1[4 * g4 + 3] * linv);
    *(u32x2*)(yo + 8 * g4) = w0; *(u32x2*)(yo + 32 + 8 * g4) = w1;
  }
}
#ifndef EN_HY
#define EN_HY 1
#endif
#ifndef EN_SG
#define EN_SG 1
#endif
#ifndef EN_AT
#define EN_AT 1
#endif
#ifndef REP_GEMM
#define REP_GEMM 1
#endif
#ifndef REP_ATTN
#define REP_ATTN 1
#endif
#ifndef REP_HY
#define REP_HY 1
#endif
#ifndef REP_P0
#define REP_P0 1
#endif
#ifndef REP_PREP
#define REP_PREP 1
#endif
#ifndef REP_SGU
#define REP_SGU 1
#endif
#ifndef REP_SYNC
#define REP_SYNC 1
#endif
#ifndef REP_UP
#define REP_UP 1
#endif
#ifndef REP_DOWN
#define REP_DOWN 1
#endif
#ifndef REP_PROJ
#define REP_PROJ 1
#endif
#ifndef REP_OUT
#define REP_OUT 1
#endif
#ifndef REP_QKV
#define REP_QKV 1
#endif
template <class Epi> DI void run_gemm(unsigned char* lds, const bf16_t* A, const bf16_t* Bt, int N, int K, const Epi& E, int wv, int M = MTOT, int reps = 1, int cshift = 0) {
  pg8::Gemm g; g.A = A; g.Bt = Bt; g.M = M; g.N = N; g.K = K;
  pg8::StaticOrder S; S.init(M, N, (int)gridDim.x, (int)((blockIdx.x + cshift) % gridDim.x)); S.ntk = K / 64;
  for (int rep = 0; rep < REP_GEMM * reps; ++rep) { Epi E2 = E; E2.wv = wv; if (rep + 1 < REP_GEMM * reps) E2.kill(); pg8::gemm_phase<Epi, pg8::StaticOrder, false>((LAS unsigned char*)lds, g, S, E2, nullptr, wv); }
}
template <class Epi> DI void run_gemm_split(unsigned char* lds, const bf16_t* A, const bf16_t* Bt, int K, int S_, const Epi& E, int wv, int reps = 1) {
  pg8::Gemm g; g.A = A; g.Bt = Bt; g.M = MTOT; g.N = 1024; g.K = K;
  pg8::SplitOrder S; S.init(K, S_, (int)gridDim.x, (int)blockIdx.x);
  for (int rep = 0; rep < REP_GEMM * reps; ++rep) { Epi E2 = E; E2.wv = wv; E2.ksub = K / S_; if (rep + 1 < REP_GEMM * reps) E2.kill(); pg8::gemm_phase<Epi, pg8::SplitOrder, false>((LAS unsigned char*)lds, g, S, E2, nullptr, wv); }
}
DI void zero_cols(const Params& P, int c0, int wv) {
  for (size_t i = (size_t)blockIdx.x * 512 + otid(wv); i < (size_t)MTOT * 32; i += (size_t)gridDim.x * 512) {
    const size_t r = i >> 5, ch = i & 31; *(u32x4*)((bf16_t*)(P.ws + OFF_H) + r * 1024 + c0 + ch * 8) = (u32x4){0, 0, 0, 0}; }
}
__global__ void __launch_bounds__(512) fwd_megakernel(Params P) {
  cg::grid_group grid = cg::this_grid();
  extern __shared__ __attribute__((aligned(16))) unsigned char lds[];
  const int wv = __builtin_amdgcn_readfirstlane(threadIdx.x >> 6);
  gchar* ws = ows(P);
  bf16_t* H = (bf16_t*)(ws + OFF_H); bf16_t* AFF = (bf16_t*)(ws + OFF_R1);
  if (blockIdx.x == 0) for (int i = threadIdx.x; i < XCD_BAR_WORDS; i += 512) ((unsigned*)(P.ws + OFF_BAR))[i] = 0u;
  if (threadIdx.x < 4) ((LAS unsigned*)((LAS unsigned char*)lds + LDS_ST_OFF))[threadIdx.x] = 0u;
  grid.sync();
  if (threadIdx.x == 0) (void)xb_add(&((unsigned*)(P.ws + OFF_BAR))[XB_XCNT(xb_xcc_id())], 1u);
  for (int rep = 0; rep < REP_P0; ++rep) phase0(P, lds, wv);
  gsync(P, lds, wv);
  for (int l = 0; l < 2; ++l) {
    const bf16_t* WL = (const bf16_t*)(ws + OFF_W) + (size_t)l * WL_ELEMS;
    const float* mod = (const float*)(ws + OFF_MOD) + (size_t)l * 5 * 9216;
    for (int rep = 0; rep < REP_PREP; ++rep) { if (l == 0) prep_phase<true>(P, l, 0, wv); else prep_phase<false>(P, l, 0, wv, MTOT, 8); }
    for (int rep = 0; rep < REP_SYNC; ++rep) gsync(P, lds, wv);
    { EpiSwiglu E; E.O = AFF; run_gemm(lds, H, WL + WO_UP1, 5632, 1024, E, wv, MTOT, REP_UP); }
    for (int rep = 0; rep < REP_SYNC; ++rep) gsync(P, lds, wv);
    { EpiResid E; E.xb = (bf16_t*)(ws + OFF_XB); E.xc = (float*)(ws + OFF_XC); E.part = (float*)(ws + OFF_PART); E.mod = mod + 2 * 1024; E.coef = 0.5f; run_gemm_split(lds, AFF, WL + WO_D1, DFF, 8, E, wv, REP_DOWN); }
    for (int rep = 0; rep < REP_SYNC; ++rep) gsync(P, lds, wv);
    for (int rep = 0; rep < REP_PREP; ++rep) prep_phase<false>(P, l, 3, wv, MTOT, 8);
    for (int rep = 0; rep < REP_SYNC; ++rep) gsync(P, lds, wv);
    { EpiProj E; E.ws = ws; run_gemm(lds, H, WL + WO_IN, NINP, 1024, E, wv, MTOT, REP_PROJ); }
    for (int rep = 0; rep < REP_SYNC; ++rep) gsync(P, lds, wv);
#if EN_HY
    for (int c = blockIdx.x; c < 256 * REP_HY; c += gridDim.x) hyena_item(P, l, c & 255, (LAS unsigned char*)lds, wv);
#else
    zero_cols(P, 0, wv);
#endif
    __syncthreads();
    for (int rep = 0; rep < REP_SGU; ++rep) { const MixC mc = mixprep_consts(P, l, wv);
    for (int r = blockIdx.x * 8 + wv; r < MTOT; r += gridDim.x * 16) { mixprep_row(P, l, r, wv, mc); if (r + (int)gridDim.x * 8 < MTOT) mixprep_row(P, l, r + gridDim.x * 8, wv, mc); } }
    for (int rep = 0; rep < REP_SYNC; ++rep) gsync(P, lds, wv);
#if EN_SG
    { const int nsg = l == 1 ? 256 : 272;
      for (int it = gridDim.x - 1 - blockIdx.x; it < nsg * REP_SGU; it += gridDim.x) sgu_item(P, l, it % nsg, lds, wv); }
#else
    zero_cols(P, 256, wv);
#endif
    { EpiQ E; E.ws = ws; run_gemm(lds, (const bf16_t*)(ws + OFF_CQN), WL + WO_UQ, 768, 384, E, wv, MTOT, REP_QKV); }
    { EpiKV E; E.ws = ws; run_gemm(lds, (const bf16_t*)(ws + OFF_CKVN), WL + WO_UKV, 1024, 256, E, wv, MTOT, REP_QKV, 52); }
    for (int rep = 0; rep < REP_SYNC; ++rep) gsync(P, lds, wv);
#if EN_AT
    for (int it0 = blockIdx.x; it0 < 544 * REP_ATTN; it0 += gridDim.x) { const int it = it0 % 544;
      int item;
      if (it < 512) { const int c = it & 255, k = it >> 8, xcd = c & 7, slot = c >> 3; item = (16 * k + 2 * xcd + (slot >> 4)) * 17 + 1 + (slot & 15); }
      else item = (it - 512) * 17;
      if (l == 1 && it >= 512) continue; attn_item(P, item, lds, wv); }
#else
    zero_cols(P, 512, wv); zero_cols(P, 768, wv);
#endif
    for (int rep = 0; rep < REP_SYNC; ++rep) gsync(P, lds, wv);
    { EpiResid E; E.xb = (bf16_t*)(ws + OFF_XB); E.xc = (float*)(ws + OFF_XC); E.part = (float*)(ws + OFF_PART); E.mod = mod + 5 * 1024; E.coef = 1.0f; if (l == 1) run_gemm(lds, H, WL + WO_OUT, 1024, 1024, E, wv, NLAT, REP_OUT); else run_gemm_split(lds, H, WL + WO_OUT, 1024, 4, E, wv, REP_OUT); }
    for (int rep = 0; rep < REP_SYNC; ++rep) gsync(P, lds, wv);
    for (int rep = 0; rep < REP_PREP; ++rep) prep_phase<false>(P, l, 6, wv, l == 1 ? NLAT : MTOT, l == 1 ? 0 : 4);
    for (int rep = 0; rep < REP_SYNC; ++rep) gsync(P, lds, wv);
    { EpiSwiglu E; E.O = AFF; run_gemm(lds, H, WL + WO_UP2, 5632, 1024, E, wv, l == 1 ? NLAT : MTOT); }
    for (int rep = 0; rep < REP_SYNC; ++rep) gsync(P, lds, wv);
    { EpiResid E; E.xb = (bf16_t*)(ws + OFF_XB); E.xc = (float*)(ws + OFF_XC); E.part = (float*)(ws + OFF_PART); E.mod = mod + 8 * 1024; E.coef = 0.5f; if (l == 1) run_gemm(lds, AFF, WL + WO_D2, 1024, DFF, E, wv, NLAT); else run_gemm_split(lds, AFF, WL + WO_D2, DFF, 8, E, wv); }
    for (int rep = 0; rep < REP_SYNC; ++rep) gsync(P, lds, wv);
  }
  final_phase(P, wv);
}

extern "C" void kernel_launch(void* const* d_in, const int* in_sizes, int n_in, void* d_out, int out_size, void* d_ws, size_t ws_size, hipStream_t stream) {
  constexpr size_t kDynLds = 150528;
  static int grid_blocks = 0;
  if (!grid_blocks) {
    (void)hipFuncSetAttribute((const void*)fwd_megakernel, hipFuncAttributeMaxDynamicSharedMemorySize, (int)kDynLds);
    int dev = 0, cus = 0, per_cu = 0;
    (void)hipGetDevice(&dev);
    (void)hipDeviceGetAttribute(&cus, hipDeviceAttributeMultiprocessorCount, dev);
    (void)hipOccupancyMaxActiveBlocksPerMultiprocessor(&per_cu, fwd_megakernel, 512, kDynLds);
    grid_blocks = cus > 0 ? cus : 256;
    if (ws_size < WS_END) fprintf(stderr, "workspace too small: %zu < %zu\n", ws_size, (size_t)WS_END);
  }
  Params p{};
  for (int i = 0; i < 32 && i < n_in; ++i) p.in[i] = (const float*)d_in[i];
  p.out = (float*)d_out; p.ws = (char*)d_ws;
  void* args[] = {&p};
  hipError_t e = hipLaunchCooperativeKernel((void*)fwd_megakernel, dim3(grid_blocks), dim3(512), args, kDynLds, stream);
  if (e != hipSuccess) fprintf(stderr, "cooperative launch failed: %s (grid %d)\n", hipGetErrorString(e), grid_blocks);
}
```

```cpp
#include <hip/hip_runtime.h>
#include <hip/hip_cooperative_groups.h>
#include <cstdio>
namespace cg = cooperative_groups;

#define LAS __attribute__((address_space(3)))
#define DI __device__ __forceinline__
typedef unsigned short bf16_t;
typedef short bf16x8 __attribute__((ext_vector_type(8)));
typedef short s16x4 __attribute__((ext_vector_type(4)));
typedef float f32x4 __attribute__((ext_vector_type(4)));
typedef float f32x2 __attribute__((ext_vector_type(2)));
typedef float f32x16 __attribute__((ext_vector_type(16)));
typedef unsigned u32x4 __attribute__((ext_vector_type(4)));
typedef unsigned u32x2 __attribute__((ext_vector_type(2)));
typedef __bf16 bf16x2_t __attribute__((ext_vector_type(2)));

struct Params { const float* in[32]; float* out; char* ws; };

constexpr int NLAT = 16384, MTOT = 17408, DM = 1024, DFF = 2816, NIN = 1952, NINP = 2048, NPOS = 4352;
enum { I_X = 0, I_C, I_CTX, I_CCTX, I_ADAW, I_ADAB, I_F1G, I_F1U, I_F1D, I_WIN, I_WOUT, I_HCW, I_HCB, I_HW1, I_HB1, I_HW2, I_HB2, I_HW3, I_HFREQ, I_HBIAS,
       I_SGG, I_SGB, I_SGW, I_SGBS, I_QN, I_WUQ, I_KVN, I_WUKV, I_F2G, I_F2U, I_F2D, I_FN };
constexpr size_t OFF_XC = 0;
constexpr size_t OFF_H = OFF_XC + (size_t)1024 * 1024 * 4;
constexpr size_t OFF_R1 = OFF_H + (size_t)MTOT * 1024 * 2;
constexpr size_t OFF_PROJ = OFF_R1;
constexpr size_t OFF_PT = OFF_PROJ + (size_t)MTOT * NINP * 2;
constexpr size_t OFF_PTC = OFF_PT + (size_t)4 * 768 * 4096 * 2;
constexpr size_t OFF_Q = OFF_PROJ;
constexpr size_t OFF_KN = OFF_Q + (size_t)32 * NPOS * 96 * 2;
constexpr size_t OFF_VT = OFF_KN + (size_t)32 * NPOS * 64 * 2;
constexpr size_t OFF_R2 = OFF_R1 + (size_t)MTOT * DFF * 2;
constexpr size_t OFF_PART = OFF_R2;
constexpr size_t OFF_CQN = OFF_R2;
constexpr size_t OFF_CKVN = OFF_CQN + (size_t)MTOT * 384 * 2;
constexpr size_t OFF_KR = OFF_CKVN + (size_t)MTOT * 256 * 2;
constexpr size_t OFF_UG = OFF_KR + (size_t)4 * NPOS * 32 * 2;
constexpr size_t OFF_VN = OFF_UG + (size_t)MTOT * 256 * 2;
constexpr size_t OFF_W = OFF_VN + (size_t)MTOT * 256 * 2;
constexpr size_t WO_UP1 = 0, WO_UP2 = 5767168, WO_D1 = 11534336, WO_D2 = 14417920, WO_IN = 17301504, WO_OUT = 19398656, WO_UQ = 20447232, WO_UKV = 20742144, WO_S = 21004288, WL_ELEMS = 21069824;
constexpr size_t OFF_MOD = OFF_W + 2 * WL_ELEMS * 2;
constexpr size_t OFF_H2 = OFF_MOD + (size_t)2 * 5 * 9216 * 4;
constexpr size_t OFF_H2C = OFF_H2 + (size_t)2 * 4096 * 64 * 4;
constexpr size_t OFF_TW = OFF_H2C + (size_t)2 * 256 * 64 * 4;
constexpr size_t OFF_ROPE = OFF_TW + 4096 * 8;
constexpr size_t OFF_XB = OFF_ROPE + 64 * 8 * 8;
constexpr size_t OFF_BAR = OFF_XB + (size_t)NLAT * 1024 * 2;
constexpr size_t WS_END = OFF_BAR + 16384;
static_assert(OFF_VT + (size_t)32 * NPOS * 64 * 2 <= OFF_PT, "alias overflow");
static_assert(OFF_PTC + (size_t)4 * 768 * 256 * 2 <= OFF_R2, "R1 overflow");

DI int otid(int wv) { int ln; asm volatile("v_mbcnt_lo_u32_b32 %0, -1, 0\n\tv_mbcnt_hi_u32_b32 %0, -1, %0" : "=&v"(ln)); return (wv << 6) | ln; }
DI unsigned pk_bf16(float a, float b) { f32x2 v = {a, b}; bf16x2_t r = __builtin_convertvector(v, bf16x2_t); return __builtin_bit_cast(unsigned, r); }
DI bf16_t f2bf(float a) { return (bf16_t)(pk_bf16(a, a) & 0xffffu); }
DI float bf2f(bf16_t u) { return __uint_as_float(((unsigned)u) << 16); }
DI float silu_f(float g) { return g * __builtin_amdgcn_rcpf(1.f + __expf(-g)); }
typedef __attribute__((address_space(1))) char gchar;
DI gchar* ows(const Params& P) {
  const unsigned long long w = (unsigned long long)P.ws; unsigned lo = (unsigned)w, hi = (unsigned)(w >> 32);
  asm volatile("" : "+v"(lo), "+v"(hi));
  lo = __builtin_amdgcn_readfirstlane(lo); hi = __builtin_amdgcn_readfirstlane(hi);
  return (gchar*)(((unsigned long long)hi << 32) | lo);
}
DI float rdlane_c(float v, int i) { return __builtin_bit_cast(float, __builtin_amdgcn_readlane(__builtin_bit_cast(int, v), i)); }
DI float xshfl(float v, int lane, int o) { return __builtin_bit_cast(float, __builtin_amdgcn_ds_bpermute((lane ^ o) << 2, __builtin_bit_cast(int, v))); }
#define DPP_F(v, ctrl) __builtin_bit_cast(float, __builtin_amdgcn_update_dpp(0, __builtin_bit_cast(int, (v)), (ctrl), 0xf, 0xf, true))
DI float wave_sum(float v, int lane) {
  v += DPP_F(v, 0xB1); v += DPP_F(v, 0x4E); v += DPP_F(v, 0x141); v += DPP_F(v, 0x140);
  return (rdlane_c(v, 0) + rdlane_c(v, 16)) + (rdlane_c(v, 32) + rdlane_c(v, 48));
}
DI float gelu_f(float v) {
  const float av = __builtin_fabsf(v), t = __builtin_amdgcn_rcpf(av * 0.2316418882f + 1.0f);
  float q = t * 0.5307027145f + (-0.7265760135f); q = q * t + 0.7107068705f; q = q * t + (-0.142248368f); q = q * t + 0.127414796f; q = q * t;
  const float e = __builtin_amdgcn_exp2f((v * v) * (-0.72134752044f)), m = v * (q * e);
  return v < 0.f ? m : v - m;
}
DI float rdlane(float v, int i) { return __builtin_bit_cast(float, __builtin_amdgcn_readlane(__builtin_bit_cast(int, v), i)); }
DI void row_bp(int r, int& b, int& p) { if (r < NLAT) { b = r >> 12; p = 256 + (r & 4095); } else { const int rc = r - NLAT; b = rc >> 8; p = rc & 255; } }
DI f32x4 bf4_to_f32(u32x2 w) { return (f32x4){__uint_as_float(w.x << 16), __uint_as_float(w.x & 0xffff0000u), __uint_as_float(w.y << 16), __uint_as_float(w.y & 0xffff0000u)}; }
DI u32x2 f32_to_bf4(f32x4 v) { u32x2 w; w.x = pk_bf16(v[0], v[1]); w.y = pk_bf16(v[2], v[3]); return w; }
DI f32x4 xload(const Params& P, int r, int c) {
  if (r < NLAT) return bf4_to_f32(*(const u32x2*)((const bf16_t*)(ows(P) + OFF_XB) + (size_t)r * 1024 + c));
  return *(const f32x4*)((const float*)(ows(P) + OFF_XC) + (size_t)(r - NLAT) * 1024 + c);
}
DI void xstore(const Params& P, int r, int c, f32x4 v) {
  if (r < NLAT) *(u32x2*)((bf16_t*)(ows(P) + OFF_XB) + (size_t)r * 1024 + c) = f32_to_bf4(v);
  else *(f32x4*)((float*)(ows(P) + OFF_XC) + (size_t)(r - NLAT) * 1024 + c) = v;
}

#define XB_TMO      128
#define XB_XCNT(j)  (256  + 64 * (j))
#define XB_XSUB(j)  (1280 + 64 * (j))
#define XB_XGEN(j)  (2304 + 64 * (j))
#define XB_TOP      3328
#define XB_TOPGEN   3392
#define XCD_BAR_WORDS 3456
#define XB_SPIN_CAP (1u << 20)
constexpr int LDS_ST_OFF = 133120;
constexpr int LDS_TW2_OFF = 133632;
DI unsigned xb_ld(unsigned* p) { return __hip_atomic_load(p, __ATOMIC_RELAXED, __HIP_MEMORY_SCOPE_AGENT); }
DI unsigned xb_add(unsigned* p, unsigned v) { return __hip_atomic_fetch_add(p, v, __ATOMIC_RELAXED, __HIP_MEMORY_SCOPE_AGENT); }
DI unsigned xb_xcc_id() { return (unsigned)__builtin_amdgcn_s_getreg((3 << 11) | 20) & 0xFu; }
#define XB_SPIN(cond, bar) do { unsigned _sp = 0; while (cond) { __builtin_amdgcn_s_sleep(1); \
    if ((++_sp & 255u) == 0u) { if (xb_ld(&(bar)[XB_TMO])) break; if (_sp > XB_SPIN_CAP) { atomicAdd(&(bar)[XB_TMO], 1u); break; } } } } while (0)
DI void xcd_barrier_complete(unsigned* bar, unsigned x, unsigned& nloc, unsigned& nx) {
  const unsigned G = gridDim.x;
  unsigned sum, cnt, mine, sp = 0u;
  for (;;) {
    sum = 0u; cnt = 0u; mine = 0u;
#pragma unroll
    for (unsigned j = 0; j < 16; ++j) { const unsigned c = xb_ld(&bar[XB_XCNT(j)]); sum += c; cnt += (c > 0u) ? 1u : 0u; mine = (j == x) ? c : mine; }
    if (sum == G) break;
    __builtin_amdgcn_s_sleep(1);
    if ((++sp & 255u) == 0u) { if (xb_ld(&bar[XB_TMO])) break; if (sp > XB_SPIN_CAP) { atomicAdd(&bar[XB_TMO], 1u); break; } }
  }
  nloc = mine > 0u ? mine : 1u; nx = cnt > 0u ? cnt : 1u;
}
DI void gsync(const Params& P, unsigned char* lds, int wv) {
  asm volatile("s_waitcnt vmcnt(0)" ::: "memory");
  __syncthreads();
  if (wv == 0 && __builtin_amdgcn_mbcnt_lo(~0u, 0u) == 0 && __builtin_amdgcn_mbcnt_hi(~0u, 0u) == 0) {
    unsigned* bar = (unsigned*)(ows(P) + OFF_BAR);
    volatile LAS unsigned* st = (volatile LAS unsigned*)((LAS unsigned char*)lds + LDS_ST_OFF);
    const unsigned x = xb_xcc_id();
    __builtin_amdgcn_s_waitcnt(0);
    unsigned nloc = st[0], nx = st[1];
    if (nloc == 0u) { xcd_barrier_complete(bar, x, nloc, nx); st[0] = nloc; st[1] = nx; }
    const unsigned old = xb_add(&bar[XB_XSUB(x)], 1u);
    const unsigned gen = old / nloc;
    if (old + 1u == (gen + 1u) * nloc) {
      __builtin_amdgcn_fence(__ATOMIC_RELEASE, "agent");
      asm volatile("s_waitcnt vmcnt(0)" ::: "memory");
      const unsigned og = xb_add(&bar[XB_TOP], 1u);
      const unsigned tg = og / nx;
      if (og + 1u == (tg + 1u) * nx) xb_add(&bar[XB_TOPGEN], 1u);
      else XB_SPIN(xb_ld(&bar[XB_TOPGEN]) == tg, bar);
      __builtin_amdgcn_fence(__ATOMIC_ACQUIRE, "agent");
      xb_add(&bar[XB_XGEN(x)], 1u);
      asm volatile("s_waitcnt vmcnt(0)" ::: "memory");
    } else {
      XB_SPIN(xb_ld(&bar[XB_XGEN(x)]) == gen, bar);
      __builtin_amdgcn_fence(__ATOMIC_ACQUIRE, "agent");
      asm volatile("s_waitcnt vmcnt(0)" ::: "memory");
    }
  }
  __syncthreads();
}
namespace pg8 {
#define PG8_LAS __attribute__((address_space(3)))
constexpr int BM = 256, BK = 64, HALF = 128, HTB = HALF * BK * 2  , STAGE_BYTES = 8 * HTB, NXCD = 8, WGM = 4;
__host__ __device__ __forceinline__ int lds_byte(int r, int c) { const int st = (r >> 4) * 2 + (c >> 5), rr = r & 15, cc = c & 31, ob = rr * 64 + cc * 2; return st * 1024 + (ob ^ (((ob >> 9) & 1) << 5)); }
__host__ __device__ __forceinline__ void stage_rc(int b, int& R, int& C) { const int st = b / 1024, sb = b % 1024, swz = sb ^ (((sb >> 9) & 1) << 5); R = (st >> 1) * 16 + swz / 64; C = (st & 1) * 32 + (swz % 64) / 2; }
__host__ __device__ __forceinline__ int perm32(int rho) { const int n = rho >> 4, i = rho & 15; return 8 * (i >> 2) + 4 * n + (i & 3); }

struct Unit { int pm, pn, koff, nt; };
struct Gemm { const bf16_t* A; const bf16_t* Bt; int M, N, K; };
struct StaticOrder {
    int nM, nN, nwg, G, c, ntk;
    __host__ __device__ void init(int M, int N, int G_, int c_) { nM = M / BM; nN = N / BM; nwg = nM * nN; G = G_; c = c_; }
    __host__ __device__ bool next(int i, Unit& u) const {
        const long L = (long)i * G + c; if (L >= nwg) return false;
        int wgid = (int)L; { const int q = nwg / NXCD, r = nwg % NXCD, xcd = wgid % NXCD, off = wgid / NXCD; wgid = (xcd < r ? xcd * (q + 1) : r * (q + 1) + (xcd - r) * q) + off; }
        const int nig = WGM * nN, gid = wgid / nig, fm = gid * WGM, gsz = (nM - fm) < WGM ? (nM - fm) : WGM;
        u.pm = fm + ((wgid % nig) % gsz); u.pn = (wgid % nig) / gsz; u.koff = 0; u.nt = ntk; return true;
    }
    __device__ __forceinline__ void a_ready(const Unit&) const {}
    __device__ __forceinline__ void done(const Unit&) const {}
};
struct SplitOrder {
    StaticOrder lat; int S, ksub, rounds, uneven;
    __device__ void init(int K, int S_, int G_, int c_) { lat.init(16384, 1024, G_, c_); lat.ntk = K / BK; S = S_; ksub = K / S_; rounds = (lat.nwg + G_ - 1) / G_; uneven = (K == 2816 && S_ == 8); }
    __device__ bool next(int i, Unit& u) const {
        const int nlat = lat.c < lat.nwg ? (lat.nwg - lat.c + lat.G - 1) / lat.G : 0;
        if (i < nlat) return lat.next(i, u);
        const int e = (i - nlat) * lat.G + lat.c; if (e >= 16 * S) return false;
        const int j = e / S, s = e - j * S; u.pm = 64 + (j >> 2); u.pn = j & 3;
        if (uneven) { const int q4 = s >> 2, r4 = s & 3; u.koff = (q4 * 22 + r4 * 6) * BK; u.nt = r4 == 3 ? 4 : 6; }
        else { u.koff = s * ksub; u.nt = ksub / BK; }
        return true;
    }
    __device__ __forceinline__ void a_ready(const Unit&) const {}
    __device__ __forceinline__ void done(const Unit&) const {}
};
template <class Epi, class Sched, bool STAMP = false>
__device__ __forceinline__ void gemm_phase(PG8_LAS unsigned char* lds, const Gemm g, const Sched& S, const Epi& E, unsigned long long* stamps, int wv) {
    const int tid = otid(wv), wid = __builtin_amdgcn_readfirstlane(tid >> 6), lane = tid & 63, wr = wid >> 2, wc = wid & 3, fr = lane & 15, fq = lane >> 4;
    const int K = g.K;
#define PG8_STAMP() do {} while (0)
    unsigned voffA[2], voffB[2];
#pragma unroll
    for (int i = 0; i < 2; ++i) { int R, C; stage_rc(tid * 16 + i * 8192, R, C); const int Rb = Epi::PERM ? ((R & ~31) + perm32(R & 31)) : R;
        voffA[i] = (unsigned)(R * K + C) * 2u; voffB[i] = (unsigned)(Rb * K + C) * 2u; }
    const size_t kstep = (size_t)(BK * 2);
    const size_t hstep = (size_t)HALF * K * 2;
    const size_t tstep = 2 * hstep;
    const unsigned ldsw = (unsigned)wid * 1024u;
    const int aoff = lds_byte(wr * 64 + fr, fq * 8), boff = lds_byte(wc * 32 + fr, fq * 8);
#define PG8_SA(b, h) (((b) * 2 + (h)) * HTB)
#define PG8_SB(b, h) ((4 + (b) * 2 + (h)) * HTB)
#define PG8_STAGE(bufoff, gbase, voff) do { _Pragma("unroll") for (int _i = 0; _i < 2; ++_i) \
        __builtin_amdgcn_global_load_lds((const unsigned*)((const char*)(gbase) + (voff)[_i]), (PG8_LAS unsigned*)(lds + (bufoff) + ldsw + _i * 8192), 16, 0, 0); } while (0)
#define PG8_LDA(dst, b, h) do { _Pragma("unroll") for (int m = 0; m < 4; ++m) _Pragma("unroll") for (int k = 0; k < 2; ++k) dst[m][k] = *(const PG8_LAS bf16x8*)(lds + PG8_SA(b, h) + aoff + m * 2048 + k * 1024); } while (0)
#define PG8_LDB(dst, b, h) do { _Pragma("unroll") for (int n = 0; n < 2; ++n) _Pragma("unroll") for (int k = 0; k < 2; ++k) dst[n][k] = *(const PG8_LAS bf16x8*)(lds + PG8_SB(b, h) + boff + n * 2048 + k * 1024); } while (0)
#define PG8_MMA(ai, bj, At, Bt) do { __builtin_amdgcn_s_setprio(1); _Pragma("unroll") for (int m = 0; m < 4; ++m) _Pragma("unroll") for (int n = 0; n < 2; ++n) _Pragma("unroll") for (int k = 0; k < 2; ++k) \
        acc[ai][bj][m][n] = __builtin_amdgcn_mfma_f32_16x16x32_bf16(Bt[n][k], At[m][k], acc[ai][bj][m][n], 0, 0, 0); __builtin_amdgcn_s_setprio(0); } while (0)
#define PG8_WAIT_V(n) asm volatile("s_waitcnt vmcnt(" #n ")" ::: "memory")
#define PG8_WAIT_L(n) asm volatile("s_waitcnt lgkmcnt(" #n ")" ::: "memory")
#define PG8_BAR __builtin_amdgcn_s_barrier()
#define PG8_SCHED __builtin_amdgcn_sched_barrier(0)
    Unit cur, nxt; int ui = 0;
    if (!S.next(0, cur)) return;
    f32x4 acc[2][2][4][2];
#pragma unroll
    for (int a = 0; a < 2; ++a)
#pragma unroll
        for (int b = 0; b < 2; ++b)
#pragma unroll
            for (int m = 0; m < 4; ++m)
#pragma unroll
                for (int n = 0; n < 2; ++n) acc[a][b][m][n] = (f32x4){0.f, 0.f, 0.f, 0.f};
    bf16x8 At[4][2], B0[2][2], B1[2][2];
    const char* cA = (const char*)g.A + (size_t)cur.pm * tstep + (size_t)cur.koff * 2; const char* cB = (const char*)g.Bt + (size_t)cur.pn * tstep + (size_t)cur.koff * 2;
    S.a_ready(cur);
    PG8_STAGE(PG8_SB(0, 0), cB, voffB); PG8_STAGE(PG8_SA(0, 0), cA, voffA); PG8_STAGE(PG8_SB(0, 1), cB + hstep, voffB); PG8_STAGE(PG8_SA(0, 1), cA + hstep, voffA);
    if (wr == 1) PG8_BAR;
    PG8_WAIT_V(4); PG8_BAR;
    PG8_STAGE(PG8_SB(1, 0), cB + kstep, voffB); PG8_STAGE(PG8_SA(1, 0), cA + kstep, voffA); PG8_STAGE(PG8_SB(1, 1), cB + hstep + kstep, voffB);
    PG8_WAIT_V(6); PG8_BAR;
    for (;;) {
        const bool has_next = S.next(ui + 1, nxt);
        const char* nA = has_next ? (const char*)g.A + (size_t)nxt.pm * tstep + (size_t)nxt.koff * 2 : cA; const char* nB = has_next ? (const char*)g.Bt + (size_t)nxt.pn * tstep + (size_t)nxt.koff * 2 : cB;
        const int nt = cur.nt;
        for (int t = 0; t < nt; t += 2) {
            const bool last = (t == nt - 2);
            const char* a1 = cA + (size_t)(t + 1) * kstep;
            const char* a2 = last ? nA : cA + (size_t)(t + 2) * kstep; const char* b2 = last ? nB : cB + (size_t)(t + 2) * kstep;
            const char* a3 = a2 + kstep; const char* b3 = b2 + kstep;
            if (last && has_next) S.a_ready(nxt);
            PG8_LDB(B0, 0, 0); PG8_SCHED; PG8_LDA(At, 0, 0); PG8_STAGE(PG8_SA(1, 1), a1 + hstep, voffA);
            PG8_WAIT_L(8); PG8_BAR; PG8_WAIT_L(0); PG8_MMA(0, 0, At, B0); PG8_BAR; PG8_SCHED;
            PG8_LDB(B1, 0, 1); PG8_STAGE(PG8_SB(0, 0), b2, voffB);
            PG8_BAR; PG8_WAIT_L(0); PG8_MMA(0, 1, At, B1); PG8_BAR;
            PG8_LDA(At, 0, 1); PG8_STAGE(PG8_SA(0, 0), a2, voffA);
            PG8_BAR; PG8_WAIT_L(0); PG8_MMA(1, 0, At, B0); PG8_BAR; PG8_SCHED;
            PG8_STAGE(PG8_SB(0, 1), b2 + hstep, voffB);
            PG8_WAIT_V(6); PG8_BAR; PG8_MMA(1, 1, At, B1); PG8_BAR;
            PG8_LDB(B0, 1, 0); PG8_SCHED; PG8_LDA(At, 1, 0); PG8_STAGE(PG8_SA(0, 1), a2 + hstep, voffA);
            PG8_WAIT_L(8); PG8_BAR; PG8_WAIT_L(0); PG8_MMA(0, 0, At, B0); PG8_BAR; PG8_SCHED;
            PG8_LDB(B1, 1, 1); PG8_STAGE(PG8_SB(1, 0), b3, voffB);
            PG8_BAR; PG8_WAIT_L(0); PG8_MMA(0, 1, At, B1); PG8_BAR;
            PG8_LDA(At, 1, 1); PG8_STAGE(PG8_SA(1, 0), a3, voffA);
            PG8_BAR; PG8_WAIT_L(0); PG8_MMA(1, 0, At, B0); PG8_BAR; PG8_SCHED;
            PG8_STAGE(PG8_SB(1, 1), b3 + hstep, voffB);
            PG8_WAIT_V(6); PG8_BAR; PG8_MMA(1, 1, At, B1); PG8_BAR;
        }
        if constexpr (!Epi::AFTER_DRAIN) { E(acc, cur, wr, wc, fr, fq); S.done(cur); }
        if (!has_next) break;
#pragma unroll
        for (int a = 0; a < 2; ++a)
#pragma unroll
            for (int b = 0; b < 2; ++b)
#pragma unroll
                for (int m = 0; m < 4; ++m)
#pragma unroll
                    for (int n = 0; n < 2; ++n) acc[a][b][m][n] = (f32x4){0.f, 0.f, 0.f, 0.f};
        cur = nxt; cA = nA; cB = nB; ++ui;
    }
    PG8_WAIT_V(0);
    if (wr == 0) PG8_BAR;
    PG8_BAR;
    if constexpr (Epi::AFTER_DRAIN) { E.fused(acc, cur, wr, wc, fr, fq, lds, wid, lane); S.done(cur); }
#undef PG8_STAMP
#undef PG8_SA
#undef PG8_SB
#undef PG8_STAGE
#undef PG8_LDA
#undef PG8_LDB
#undef PG8_MMA
#undef PG8_WAIT_V
#undef PG8_WAIT_L
#undef PG8_BAR
#undef PG8_SCHED
}
}
#ifndef KILL_SKIPS_EPI
#define KILL_SKIPS_EPI 0
#endif
using pg8::Unit; using pg8::HALF; using pg8::BM;
struct EpiSwiglu {
  static constexpr bool PERM = true, AFTER_DRAIN = false;
  bf16_t* O; int wv; int skip = 0;
  DI void kill() { skip = 1; }
  DI void operator()(const f32x4 (&acc)[2][2][4][2], const Unit& u, int wr, int wc, int fr_, int fq_) const {
    const int ln_ = otid(wv) & 63, fr = ln_ & 15, fq = ln_ >> 4;
    if (skip) return;
    const int row0 = u.pm * BM + wr * 64 + fr, col0 = u.pn * 128 + wc * 32 + 8 * fq;
#pragma unroll
    for (int ai = 0; ai < 2; ++ai)
#pragma unroll
      for (int m = 0; m < 4; ++m) {
        const f32x4 g0 = acc[ai][0][m][0], g1 = acc[ai][0][m][1], u0 = acc[ai][1][m][0], u1 = acc[ai][1][m][1];
        u32x4 w;
        w.x = pk_bf16(silu_f(g0[0]) * u0[0], silu_f(g0[1]) * u0[1]); w.y = pk_bf16(silu_f(g0[2]) * u0[2], silu_f(g0[3]) * u0[3]);
        w.z = pk_bf16(silu_f(g1[0]) * u1[0], silu_f(g1[1]) * u1[1]); w.w = pk_bf16(silu_f(g1[2]) * u1[2], silu_f(g1[3]) * u1[3]);
        *(u32x4*)(O + (size_t)(row0 + ai * HALF + m * 16) * DFF + col0) = w;
      }
  }
};
struct EpiResid {
  static constexpr bool PERM = false, AFTER_DRAIN = false;
  bf16_t* xb; float* xc; float* part; const float* mod;
  float coef; int wv; int skip = 0; int ksub = 0;
  DI void kill() { coef = 0.f; skip = KILL_SKIPS_EPI; }
  DI void operator()(const f32x4 (&acc)[2][2][4][2], const Unit& u, int wr, int wc, int fr_, int fq_) const {
    const int ln_ = otid(wv) & 63, fr = ln_ & 15, fq = ln_ >> 4;
    const int row0 = u.pm * BM + wr * 64 + fr, col0 = u.pn * BM + wc * 32 + 4 * fq;
    if (skip) return;
    const int bi = (u.pm < 64) ? (u.pm >> 4) : 4;
    const float* gp = mod + (size_t)bi * 9216 + col0;
    f32x4 gv[2][2];
#pragma unroll
    for (int bj = 0; bj < 2; ++bj)
#pragma unroll
      for (int n = 0; n < 2; ++n) gv[bj][n] = *(const f32x4*)(gp + bj * HALF + n * 16) * coef;
#pragma unroll
    for (int ai = 0; ai < 2; ++ai) {
      f32x4 xv[4][2][2];
      const bool lat = u.pm < 64;
#pragma unroll
      for (int m = 0; m < 4; ++m) {
        const int r = row0 + ai * HALF + m * 16;
        if (!(ksub && u.pm >= 64)) {
#pragma unroll
          for (int bj = 0; bj < 2; ++bj)
#pragma unroll
            for (int n = 0; n < 2; ++n) {
              const int c = col0 + bj * HALF + n * 16;
              xv[m][bj][n] = lat ? bf4_to_f32(*(const u32x2*)(xb + (size_t)r * 1024 + c)) : *(const f32x4*)(xc + (size_t)(r - NLAT) * 1024 + c);
            }
        }
      }
#pragma unroll
      for (int m = 0; m < 4; ++m)
#pragma unroll
        for (int bj = 0; bj < 2; ++bj)
#pragma unroll
          for (int n = 0; n < 2; ++n) {
            const int r = row0 + ai * HALF + m * 16, c = col0 + bj * HALF + n * 16;
            const f32x4 d = gv[bj][n] * acc[ai][bj][m][n];
            if (ksub && u.pm >= 64) *(f32x4*)(part + ((size_t)(u.koff / ksub) * 1024 + (r - NLAT)) * 1024 + c) = d;
            else if (lat) *(u32x2*)(xb + (size_t)r * 1024 + c) = f32_to_bf4(xv[m][bj][n] + d);
            else *(f32x4*)(xc + (size_t)(r - NLAT) * 1024 + c) = xv[m][bj][n] + d;
          }
    }
  }
};
struct EpiProj {
  static constexpr bool PERM = true, AFTER_DRAIN = false;
  gchar* ws; int wv;
  DI void kill() {}
  DI void operator()(const f32x4 (&acc)[2][2][4][2], const Unit& u, int wr, int wc, int fr_, int fq_) const {
    const int ln_ = otid(wv) & 63, fr = ln_ & 15, fq = ln_ >> 4;
    const int row0 = u.pm * BM + wr * 64 + fr, col0 = u.pn * BM + wc * 32 + 8 * fq;
    if (u.pn >= 3) {
      bf16_t* O = (bf16_t*)(ws + OFF_PROJ);
#pragma unroll
      for (int ai = 0; ai < 2; ++ai)
#pragma unroll
        for (int m = 0; m < 4; ++m)
#pragma unroll
          for (int bj = 0; bj < 2; ++bj) {
            const f32x4 v0 = acc[ai][bj][m][0], v1 = acc[ai][bj][m][1];
            u32x4 w; w.x = pk_bf16(v0[0], v0[1]); w.y = pk_bf16(v0[2], v0[3]); w.z = pk_bf16(v1[0], v1[1]); w.w = pk_bf16(v1[2], v1[3]);
            *(u32x4*)(O + (size_t)(row0 + ai * HALF + m * 16) * NINP + col0 + bj * HALF) = w;
          }
    } else {
#pragma unroll
      for (int ai = 0; ai < 2; ++ai)
#pragma unroll
        for (int m = 0; m < 4; ++m) {
          const int r = row0 + ai * HALF + m * 16;
          bf16_t* base; int ld;
          if (r < NLAT) { base = (bf16_t*)(ws + OFF_PT) + (size_t)(r >> 12) * 768 * 4096 + (r & 4095); ld = 4096; }
          else { const int rc = r - NLAT; base = (bf16_t*)(ws + OFF_PTC) + (size_t)(rc >> 8) * 768 * 256 + (rc & 255); ld = 256; }
#pragma unroll
          for (int bj = 0; bj < 2; ++bj)
#pragma unroll
            for (int n = 0; n < 2; ++n)
#pragma unroll
              for (int j = 0; j < 4; ++j) base[(size_t)(col0 + bj * HALF + 4 * n + j) * ld] = f2bf(acc[ai][bj][m][n][j]);
        }
    }
  }
};
struct EpiQ {
  static constexpr bool PERM = false, AFTER_DRAIN = false;
  gchar* ws; int wv;
  DI void kill() {}
  DI void operator()(const f32x4 (&acc)[2][2][4][2], const Unit& u, int wr, int wc, int fr_, int fq_) const {
    const int ln_ = otid(wv) & 63, fr = ln_ & 15, fq = ln_ >> 4;
    const float qs = 0.10206207261596577f * 1.4426950408889634f;
    const int row0 = u.pm * BM + wr * 64 + fr, col0 = u.pn * BM + wc * 32 + 4 * fq;
    bf16_t* Q = (bf16_t*)(ws + OFF_Q);
    const int b = u.pm < 64 ? (u.pm >> 4) : u.pm - 64, p0 = u.pm < 64 ? 256 + ((u.pm & 15) << 8) : 0;
    const f32x2* rope = (const f32x2*)(ws + OFF_ROPE);
#pragma unroll
    for (int ai = 0; ai < 2; ++ai)
#pragma unroll
      for (int m = 0; m < 4; ++m) {
        const int r = row0 + ai * HALF + m * 16, p = p0 + wr * 64 + fr + ai * HALF + m * 16;
#pragma unroll
        for (int bj = 0; bj < 2; ++bj)
#pragma unroll
          for (int n = 0; n < 2; ++n) {
            const int c = col0 + bj * HALF + n * 16, h = c / 96, d = c - h * 96;
            f32x4 v = acc[ai][bj][m][n];
            if (d >= 64 && r < NLAT) {
              const int rp = d - 64, a = rp >> 4, q0 = (rp & 15) >> 1, npos = r & 4095, coord = a ? (npos & 63) : (npos >> 6);
              const f32x2 cs0 = rope[coord * 8 + q0], cs1 = rope[coord * 8 + q0 + 1];
              const f32x4 t = v;
              v[0] = t[0] * cs0.x - t[1] * cs0.y; v[1] = t[1] * cs0.x + t[0] * cs0.y;
              v[2] = t[2] * cs1.x - t[3] * cs1.y; v[3] = t[3] * cs1.x + t[2] * cs1.y;
            }
            u32x2 w; w.x = pk_bf16(v[0] * qs, v[1] * qs); w.y = pk_bf16(v[2] * qs, v[3] * qs);
            *(u32x2*)(Q + ((size_t)(b * 8 + h) * NPOS + p) * 96 + d) = w;
          }
      }
  }
};
struct EpiKV {
  static constexpr bool PERM = false, AFTER_DRAIN = false;
  gchar* ws; int wv;
  DI void kill() {}
  DI void operator()(const f32x4 (&acc)[2][2][4][2], const Unit& u, int wr, int wc, int fr_, int fq_) const {
    const int ln_ = otid(wv) & 63, fr = ln_ & 15, fq = ln_ >> 4;
    const int row0 = u.pm * BM + wr * 64 + fr, col0 = u.pn * BM + wc * 32 + 4 * fq;
    bf16_t* KN = (bf16_t*)(ws + OFF_KN); bf16_t* VT = (bf16_t*)(ws + OFF_VT);
    const int b = u.pm < 64 ? (u.pm >> 4) : u.pm - 64, p0 = u.pm < 64 ? 256 + ((u.pm & 15) << 8) : 0;
#pragma unroll
    for (int ai = 0; ai < 2; ++ai)
#pragma unroll
      for (int m = 0; m < 4; ++m) {
        const int r = row0 + ai * HALF + m * 16, p = p0 + wr * 64 + fr + ai * HALF + m * 16;
#pragma unroll
        for (int bj = 0; bj < 2; ++bj)
#pragma unroll
          for (int n = 0; n < 2; ++n) {
            const int c = col0 + bj * HALF + n * 16, h = c >> 7, d = c & 127;
            const f32x4 v = acc[ai][bj][m][n];
            if (d < 64) { u32x2 w; w.x = pk_bf16(v[0], v[1]); w.y = pk_bf16(v[2], v[3]); *(u32x2*)(KN + ((size_t)(b * 8 + h) * NPOS + p) * 64 + d) = w; }
            else {
#pragma unroll
              for (int j = 0; j < 4; ++j) VT[((size_t)(b * 8 + h) * 64 + (d - 64 + j)) * NPOS + p] = f2bf(v[j]);
            }
          }
      }
  }
};
constexpr int WJ_ND[8] = {5632, 5632, 1024, 1024, 2048, 1024, 768, 1024};
constexpr int WJ_K[8] = {1024, 1024, 2816, 2816, 1024, 1024, 384, 256};
constexpr int WJ_T0[9] = {0, 352, 704, 880, 1056, 1184, 1248, 1266, 1282};
DI size_t wj_off(int j) { return j == 0 ? WO_UP1 : j == 1 ? WO_UP2 : j == 2 ? WO_D1 : j == 3 ? WO_D2 : j == 4 ? WO_IN : j == 5 ? WO_OUT : j == 6 ? WO_UQ : WO_UKV; }
struct WtLoad { f32x4 v[8]; int l, job, r0, k0, K; };
DI WtLoad wt_load(const Params& P, int gt, int tid) {
  WtLoad o;
  const int l = gt / 1282, lt = gt - l * 1282;
  int job = 0;
#pragma unroll
  for (int j = 1; j < 8; ++j) if (lt >= WJ_T0[j]) job = j;
  const int t = lt - WJ_T0[job], K = WJ_K[job], kt = K >> 6, r0 = (t / kt) * 256, k0 = (t % kt) * 64;
  const int tr4 = tid & 63, tk = tid >> 6, r = r0 + 4 * tr4;
  const float* base; int Ns, col = r;
  if (job < 2) { const int tt = r >> 8, bj = (r >> 7) & 1, c = r & 127; col = 128 * tt + c; Ns = DFF;
    base = P.in[job == 0 ? (bj ? I_F1U : I_F1G) : (bj ? I_F2U : I_F2G)] + (size_t)l * 1024 * DFF; }
  else if (job < 4) { base = P.in[job == 2 ? I_F1D : I_F2D] + (size_t)l * DFF * 1024; Ns = 1024; }
  else if (job == 4) { base = P.in[I_WIN] + (size_t)l * 1024 * NIN; Ns = NIN; if (r >= NIN) col = -1; }
  else if (job == 5) { base = P.in[I_WOUT] + (size_t)l * 1024 * 1024; Ns = 1024; }
  else if (job == 6) { base = P.in[I_WUQ] + (size_t)l * 384 * 768; Ns = 768; }
  else { base = P.in[I_WUKV] + (size_t)l * 256 * 1024; Ns = 1024; }
  if (job == 6) {
#pragma unroll
    for (int kk = 0; kk < 8; ++kk)
#pragma unroll
      for (int j = 0; j < 4; ++j) {
        const int rr = r + j, h = rr / 96, d = rr - h * 96; int cc = rr;
        if (d >= 64) { const int rp = d - 64, a = rp >> 4, q = (rp & 15) >> 1, pp = rp & 1; cc = h * 96 + 64 + a * 16 + pp * 8 + q; }
        o.v[kk][j] = base[(size_t)(k0 + tk * 8 + kk) * Ns + cc];
      }
  } else {
#pragma unroll
    for (int kk = 0; kk < 8; ++kk) o.v[kk] = col >= 0 ? __builtin_nontemporal_load((const f32x4*)(base + (size_t)(k0 + tk * 8 + kk) * Ns + col)) : (f32x4){0.f, 0.f, 0.f, 0.f};
  }
  o.l = l; o.job = job; o.r0 = r0; o.k0 = k0; o.K = K;
  return o;
}
DI void wt_store(const Params& P, const WtLoad& o, unsigned char* lds, int tid) {
  const int tr4 = tid & 63, tk = tid >> 6;
  bf16_t* tile = (bf16_t*)lds;
#pragma unroll
  for (int j = 0; j < 4; ++j) {
    u32x4 w; w.x = pk_bf16(o.v[0][j], o.v[1][j]); w.y = pk_bf16(o.v[2][j], o.v[3][j]); w.z = pk_bf16(o.v[4][j], o.v[5][j]); w.w = pk_bf16(o.v[6][j], o.v[7][j]);
    *(u32x4*)(tile + (4 * tr4 + j) * 72 + tk * 8) = w;
  }
  __syncthreads();
  bf16_t* dst = (bf16_t*)(ows(P) + OFF_W) + (size_t)o.l * WL_ELEMS + wj_off(o.job);
#pragma unroll
  for (int i = 0; i < 4; ++i) { const int idx = tid + 512 * i, rr = idx >> 3, ch = idx & 7;
    *(u32x4*)(dst + (size_t)(o.r0 + rr) * o.K + o.k0 + ch * 8) = *(const u32x4*)(tile + rr * 72 + ch * 8); }
  __syncthreads();
}
DI void ada_tile(const Params& P, int t, unsigned char* lds, int wv) {
  const int tid = otid(wv), l = t / 72, j0 = (t % 72) * 128, jl = tid & 31, ks = tid >> 5;
  const float* W = P.in[I_ADAW] + (size_t)l * 1024 * 9216 + j0 + 4 * jl;
  f32x4 acc[5];
#pragma unroll
  for (int bi = 0; bi < 5; ++bi) acc[bi] = (f32x4){0.f, 0.f, 0.f, 0.f};
#pragma unroll 8
  for (int k = ks * 64; k < ks * 64 + 64; ++k) {
    const f32x4 w4 = __builtin_nontemporal_load((const f32x4*)(W + (size_t)k * 9216));
#pragma unroll
    for (int bi = 0; bi < 5; ++bi) { const float cv = bi < 4 ? P.in[I_C][bi * 1024 + k] : P.in[I_CCTX][k]; acc[bi] += w4 * silu_f(cv); }
  }
  float* red = (float*)lds;
#pragma unroll
  for (int bi = 0; bi < 5; ++bi) *(f32x4*)(red + (ks * 5 + bi) * 128 + 4 * jl) = acc[bi];
  __syncthreads();
  for (int o = tid; o < 640; o += 512) {
    const int bi = o >> 7, j = o & 127; float s = 0.f;
#pragma unroll
    for (int k2 = 0; k2 < 16; ++k2) s += red[(k2 * 5 + bi) * 128 + j];
    ((float*)(ows(P) + OFF_MOD))[(size_t)(l * 5 + bi) * 9216 + j0 + j] = s + P.in[I_ADAB][l * 9216 + j0 + j];
  }
  __syncthreads();
}
DI void h2_pos(const Params& P, int idx, int wv) {
  const int lane = otid(wv) & 63;
  const int l = idx / 4352, rem = idx - l * 4352;
  const bool lat = rem < 4096; const int pos = lat ? rem : rem - 4096; const float L = lat ? 4096.f : 256.f;
  const float tn = (float)pos / (L - 1.f), w = 6.2831855f * (float)pos / L;
  float z = 0.f;
  if (lane == 0) z = tn;
  else if (lane < 33) { const int i = (lane - 1) & 15; const float band = 1e-4f + (float)i * ((15.f - 1e-4f) / 15.f), ang = w * band; z = lane < 17 ? cosf(ang) : -sinf(ang); }
  const float* w1 = P.in[I_HW1] + (size_t)l * 33 * 64; const float* w2 = P.in[I_HW2] + (size_t)l * 64 * 64;
  float h1 = P.in[I_HB1][l * 64 + lane];
#pragma unroll
  for (int i = 0; i < 33; ++i) h1 += rdlane(z, i) * w1[i * 64 + lane];
  h1 = sinf(P.in[I_HFREQ][l * 128 + lane] * h1);
  float h2 = P.in[I_HB2][l * 64 + lane];
#pragma unroll
  for (int m = 0; m < 64; ++m) h2 += rdlane(h1, m) * w2[m * 64 + lane];
  h2 = sinf(P.in[I_HFREQ][l * 128 + 64 + lane] * h2);
  float* dst = lat ? (float*)(ows(P) + OFF_H2) + ((size_t)l * 4096 + pos) * 64 : (float*)(ows(P) + OFF_H2C) + ((size_t)l * 256 + pos) * 64;
  dst[lane] = h2;
}
DI void phase0(const Params& P, unsigned char* lds, int wv) {
  const int tid = otid(wv), wave = tid >> 6, nb = gridDim.x, bid = blockIdx.x;
  for (int i = bid * 512 + tid; i < 4096 + 512 + 2 * 65536; i += nb * 512) {
    if (i < 4096) { float s, c; sincospif(-(float)i * (1.f / 4096.f), &s, &c); ((f32x2*)(ows(P) + OFF_TW))[i] = (f32x2){c, s}; }
    else if (i < 4608) { const int k = i - 4096, coord = k >> 3, q = k & 7; const float inv = 1.0f / powf(10000.f, (float)q / 8.f), ang = (float)coord * inv;
      ((f32x2*)(ows(P) + OFF_ROPE))[k] = (f32x2){cosf(ang), sinf(ang)}; }
    else { const int k = i - 4608, l = k >> 16, e = k & 65535; ((bf16_t*)(ows(P) + OFF_W))[(size_t)l * WL_ELEMS + WO_S + e] = f2bf(P.in[I_SGW][k]); }
  }
  for (int t = bid; t < 144; t += nb) ada_tile(P, t, lds, wv);
  for (int i = bid * 8 + wave; i < 8704; i += nb * 8) h2_pos(P, i, wv);
  {
    int t = bid; WtLoad cur; if (t < 2 * 1282) cur = wt_load(P, t, tid);
    while (t < 2 * 1282) { const int tn = t + nb; WtLoad nxt; if (tn < 2 * 1282) nxt = wt_load(P, tn, tid); wt_store(P, cur, lds, tid); cur = nxt; t = tn; }
  }
}
template <bool FIRST> DI void prep_phase(const Params& P, int l, int sidx, int wv, int nrows = MTOT, int nsplit = 0) {
  const int tid = otid(wv), wave = tid >> 6, lane = tid & 63;
  const float* mod = (const float*)(ows(P) + OFF_MOD) + (size_t)l * 5 * 9216;
  bf16_t* H = (bf16_t*)(ows(P) + OFF_H);
  const int stride = gridDim.x * 8;
  int r = blockIdx.x * 8 + wave;
  f32x4 v[4];
  if (r < nrows) {
    if (FIRST) { const float* src = r < NLAT ? P.in[I_X] + (size_t)r * 1024 : P.in[I_CTX] + (size_t)(r - NLAT) * 1024;
#pragma unroll
      for (int i = 0; i < 4; ++i) v[i] = __builtin_nontemporal_load((const f32x4*)(src + i * 256 + lane * 4)); }
    else {
#pragma unroll
      for (int i = 0; i < 4; ++i) v[i] = xload(P, r, i * 256 + lane * 4); }
  }
  f32x4 scc[4], shc[4]; int bic = -1;
  while (r < nrows) {
    const int rn = r + stride; f32x4 vn[4];
    if (rn < nrows) {
      if (FIRST) { const float* src = rn < NLAT ? P.in[I_X] + (size_t)rn * 1024 : P.in[I_CTX] + (size_t)(rn - NLAT) * 1024;
#pragma unroll
        for (int i = 0; i < 4; ++i) vn[i] = __builtin_nontemporal_load((const f32x4*)(src + i * 256 + lane * 4)); }
      else {
#pragma unroll
        for (int i = 0; i < 4; ++i) vn[i] = xload(P, rn, i * 256 + lane * 4); }
    }
    const int bi = r < NLAT ? (r >> 12) : 4;
    if (bi != bic) { const float* sh = mod + (size_t)bi * 9216 + sidx * 1024; const float* sc = sh + 1024; bic = bi;
#pragma unroll
      for (int i = 0; i < 4; ++i) { scc[i] = *(const f32x4*)(sc + i * 256 + lane * 4) + 1.f; shc[i] = *(const f32x4*)(sh + i * 256 + lane * 4); } }
    if (!FIRST && nsplit > 0 && r >= NLAT) {
      const float* pp = (const float*)(ows(P) + OFF_PART) + (size_t)(r - NLAT) * 1024;
      for (int s = 0; s < nsplit; ++s)
#pragma unroll
        for (int i = 0; i < 4; ++i) v[i] += *(const f32x4*)(pp + (size_t)s * 1024 * 1024 + i * 256 + lane * 4);
#pragma unroll
      for (int i = 0; i < 4; ++i) xstore(P, r, i * 256 + lane * 4, v[i]);
    }
    float ss = 0.f;
#pragma unroll
    for (int i = 0; i < 4; ++i) ss += v[i][0] * v[i][0] + v[i][1] * v[i][1] + v[i][2] * v[i][2] + v[i][3] * v[i][3];
    ss = wave_sum(ss, lane);
    const float rs = rsqrtf(ss * (1.f / 1024.f) + 1e-6f);
#pragma unroll
    for (int i = 0; i < 4; ++i) {
      const int c = i * 256 + lane * 4;
      if (FIRST) xstore(P, r, c, v[i]);
      const f32x4 o = v[i] * rs * scc[i] + shc[i];
      u32x2 w; w.x = pk_bf16(o[0], o[1]); w.y = pk_bf16(o[2], o[3]);
      *(u32x2*)(H + (size_t)r * 1024 + c) = w;
    }
#pragma unroll
    for (int i = 0; i < 4; ++i) v[i] = vn[i];
    r = rn;
  }
}
DI void final_phase(const Params& P, int wv) {
  const int tid = otid(wv), wave = tid >> 6, lane = tid & 63;
  const float* fn = P.in[I_FN];
  f32x4 fng[4];
#pragma unroll
  for (int i = 0; i < 4; ++i) fng[i] = *(const f32x4*)(fn + i * 256 + lane * 4);
  const int stride = gridDim.x * 8;
  int r = blockIdx.x * 8 + wave;
  f32x4 v[4];
  if (r < NLAT) {
#pragma unroll
    for (int i = 0; i < 4; ++i) v[i] = xload(P, r, i * 256 + lane * 4); }
  while (r < NLAT) {
    const int rn = r + stride; f32x4 vn[4];
    if (rn < NLAT) {
#pragma unroll
      for (int i = 0; i < 4; ++i) vn[i] = xload(P, rn, i * 256 + lane * 4); }
    float* X = P.out + (size_t)r * 1024;
    float ss = 0.f;
#pragma unroll
    for (int i = 0; i < 4; ++i) ss += v[i][0] * v[i][0] + v[i][1] * v[i][1] + v[i][2] * v[i][2] + v[i][3] * v[i][3];
    ss = wave_sum(ss, lane);
    const float rs = rsqrtf(ss * (1.f / 1024.f) + 1e-6f);
#pragma unroll
    for (int i = 0; i < 4; ++i) __builtin_nontemporal_store(v[i] * rs * fng[i], (f32x4*)(X + i * 256 + lane * 4));
#pragma unroll
    for (int i = 0; i < 4; ++i) v[i] = vn[i];
    r = rn;
  }
}
typedef float cpx __attribute__((ext_vector_type(2)));
#define FD DI
#define CPX_VEC 1
FD int sw(int i) { return i ^ (((i >> 5) & 7) | (((i >> 6) & 3) << 3)); }
#ifdef CPX_VEC
FD cpx cmul(cpx a, cpx b) { return a.xx * b + a.yy * cpx{-b.y, b.x}; }
FD cpx cmulc(cpx a, cpx b) { return a.xx * cpx{b.x, -b.y} + a.yy * b.yx; }
FD cpx cadd(cpx a, cpx b) { return a + b; }
FD cpx csub(cpx a, cpx b) { return a - b; }
#else
FD cpx cmul(cpx a, cpx b) { return cpx{a.x * b.x - a.y * b.y, a.x * b.y + a.y * b.x}; }
FD cpx cmulc(cpx a, cpx b) { return cpx{a.x * b.x + a.y * b.y, a.y * b.x - a.x * b.y}; }
FD cpx cadd(cpx a, cpx b) { return cpx{a.x + b.x, a.y + b.y}; }
FD cpx csub(cpx a, cpx b) { return cpx{a.x - b.x, a.y - b.y}; }
#endif
#ifdef CPX_VEC
#define C8_H(h) const float h = 0.70710678118654752f
#else
#define C8_H(h) const float h = 0.70710678118654752f
#endif
FD cpx cmul_c8(cpx a, int q) {
  if (q == 0) return a;
  if (q == 2) return cpx{a.y, -a.x};
  C8_H(h);
  if (q == 1) return cpx{(a.x + a.y) * h, (a.y - a.x) * h};
  return cpx{(a.y - a.x) * h, -(a.x + a.y) * h};
}
FD void bfly8_dif(cpx (&x)[8], cpx w1) {
  const cpx w2 = cmul(w1, w1), w4 = cmul(w2, w2);
#pragma unroll
  for (int q = 0; q < 4; ++q) { cpx a = x[q], b = x[q + 4]; x[q] = cadd(a, b); x[q + 4] = cmul(cmul_c8(csub(a, b), q), w1); }
#pragma unroll
  for (int hf = 0; hf < 8; hf += 4)
#pragma unroll
    for (int q = 0; q < 2; ++q) { cpx a = x[hf + q], b = x[hf + q + 2]; x[hf + q] = cadd(a, b); x[hf + q + 2] = cmul(cmul_c8(csub(a, b), 2 * q), w2); }
#pragma unroll
  for (int q = 0; q < 8; q += 2) { cpx a = x[q], b = x[q + 1]; x[q] = cadd(a, b); x[q + 1] = cmul(csub(a, b), w4); }
}
template <int HALF = 0, class PT, class PTW> FD void fft_r8_dif(PT W, int lg, PTW TW, int tid) {
  const int len = 1 << lg, e = len >> 3, ts = (8192 >> lg) >> HALF;
  for (int gid = tid; gid < 1024; gid += 512) {
    const int blk = gid >> (lg - 3), j = gid & (e - 1), base = (blk << lg) + j;
    cpx x[8];
#pragma unroll
    for (int q = 0; q < 8; ++q) x[q] = W[sw(base + q * e)];
    bfly8_dif(x, TW[j * ts]);
#pragma unroll
    for (int q = 0; q < 8; ++q) W[sw(base + q * e)] = x[q];
  }
}
FD cpx cmulc_c8(cpx a, int q) {
  if (q == 0) return a;
  if (q == 2) return cpx{-a.y, a.x};
  C8_H(h);
  if (q == 1) return cpx{(a.x - a.y) * h, (a.x + a.y) * h};
  return cpx{-(a.x + a.y) * h, (a.x - a.y) * h};
}
FD void bfly8_dit(cpx (&x)[8], cpx w1) {
  const cpx w2 = cmul(w1, w1), w4 = cmul(w2, w2);
#pragma unroll
  for (int q = 0; q < 8; q += 2) { cpx a = x[q], b = cmulc(x[q + 1], w4); x[q] = cadd(a, b); x[q + 1] = csub(a, b); }
#pragma unroll
  for (int hf = 0; hf < 8; hf += 4)
#pragma unroll
    for (int q = 0; q < 2; ++q) { cpx a = x[hf + q], b = cmulc_c8(cmulc(x[hf + q + 2], w2), 2 * q); x[hf + q] = cadd(a, b); x[hf + q + 2] = csub(a, b); }
#pragma unroll
  for (int q = 0; q < 4; ++q) { cpx a = x[q], b = cmulc_c8(cmulc(x[q + 4], w1), q); x[q] = cadd(a, b); x[q + 4] = csub(a, b); }
}
template <int HALF = 0, class PT, class PTW> FD void ifft_r8_dit(PT W, int lg, PTW TW, int tid) {
  const int len = 1 << lg, e = len >> 3, ts = (8192 >> lg) >> HALF;
  for (int gid = tid; gid < 1024; gid += 512) {
    const int blk = gid >> (lg - 3), j = gid & (e - 1), base = (blk << lg) + j;
    cpx x[8];
#pragma unroll
    for (int q = 0; q < 8; ++q) x[q] = W[sw(base + q * e)];
    bfly8_dit(x, TW[j * ts]);
#pragma unroll
    for (int q = 0; q < 8; ++q) W[sw(base + q * e)] = x[q];
  }
}
template <class PT> FD void fft_r2_first(PT W, const cpx* TW, int tid) {
  for (int i = tid; i < 4096; i += 512) { cpx a = W[sw(i)], b = W[sw(i + 4096)]; W[sw(i)] = cadd(a, b); W[sw(i + 4096)] = cmul(csub(a, b), TW[i]); }
}
FD int brev13(int x) {
  unsigned v = (unsigned)x; v = ((v >> 1) & 0x55555555u) | ((v & 0x55555555u) << 1); v = ((v >> 2) & 0x33333333u) | ((v & 0x33333333u) << 2);
  v = ((v >> 4) & 0x0F0F0F0Fu) | ((v & 0x0F0F0F0Fu) << 4); v = ((v >> 8) & 0x00FF00FFu) | ((v & 0x00FF00FFu) << 8); v = (v >> 16) | (v << 16); return (int)(v >> 19);
}
template <class PT, class PF> FD void spec_mul(PT W, PF F, int o, int tid) {
  for (int pos = tid; pos < 8192; pos += 512) {
    const int k = brev13(pos), kn = (8192 - k) & 8191, posn = brev13(kn);
    const cpx Z = F[sw(pos)], Zn = F[sw(posn)];
    cpx kf;
    if (o == 0) kf = cpx{0.5f * (Z.x + Zn.x), 0.5f * (Z.y - Zn.y)};
    else        kf = cpx{0.5f * (Z.y + Zn.y), -0.5f * (Z.x - Zn.x)};
    W[sw(pos)] = cmul(W[sw(pos)], kf);
  }
}
#define MFMA32(a, b, c) __builtin_amdgcn_mfma_f32_32x32x16_bf16((a), (b), (c), 0, 0, 0)
struct MixC { float qn[6], kvn[4]; f32x4 g4, b4; };
DI MixC mixprep_consts(const Params& P, int l, int wv) {
  const int lane = otid(wv) & 63; MixC c;
#pragma unroll
  for (int i = 0; i < 6; ++i) c.qn[i] = P.in[I_QN][l * 384 + lane + 64 * i];
#pragma unroll
  for (int i = 0; i < 4; ++i) c.kvn[i] = P.in[I_KVN][l * 256 + lane + 64 * i];
  c.g4 = *(const f32x4*)(P.in[I_SGG] + l * 256 + 4 * lane); c.b4 = *(const f32x4*)(P.in[I_SGB] + l * 256 + 4 * lane);
  return c;
}
DI void mixprep_row(const Params& P, int l, int r, int wv, const MixC& C) {
  const int lane = otid(wv) & 63;
  const bf16_t* pr = (const bf16_t*)(ows(P) + OFF_PROJ) + (size_t)r * NINP;
  float q[6], k[4];
#pragma unroll
  for (int i = 0; i < 6; ++i) q[i] = bf2f(pr[1280 + lane + 64 * i]);
#pragma unroll
  for (int i = 0; i < 4; ++i) k[i] = bf2f(pr[1664 + lane + 64 * i]);
  const u32x2 ru = *(const u32x2*)(pr + 768 + 4 * lane), rv2 = *(const u32x2*)(pr + 1024 + 4 * lane);
  const int a = (lane >> 4) & 1, qq = (lane & 15) >> 1, pp = lane & 1;
  const float xs = bf2f(pr[1920 + a * 16 + pp * 8 + qq]), xp = bf2f(pr[1920 + a * 16 + (1 - pp) * 8 + qq]);
  f32x2 cs = {1.f, 0.f};
  if (r < NLAT) { const int npos = r & 4095, coord = a ? (npos & 63) : (npos >> 6); cs = ((const f32x2*)(ows(P) + OFF_ROPE))[coord * 8 + qq]; }
  float ss = 0.f;
#pragma unroll
  for (int i = 0; i < 6; ++i) ss += q[i] * q[i];
  ss = wave_sum(ss, lane);
  float rs = rsqrtf(ss * (1.f / 384.f) + 1e-6f);
  bf16_t* cq = (bf16_t*)(ows(P) + OFF_CQN) + (size_t)r * 384;
#pragma unroll
  for (int i = 0; i < 6; ++i) cq[lane + 64 * i] = f2bf(q[i] * rs * C.qn[i]);
  ss = 0.f;
#pragma unroll
  for (int i = 0; i < 4; ++i) ss += k[i] * k[i];
  ss = wave_sum(ss, lane);
  rs = rsqrtf(ss * (1.f / 256.f) + 1e-6f);
  bf16_t* ck = (bf16_t*)(ows(P) + OFF_CKVN) + (size_t)r * 256;
#pragma unroll
  for (int i = 0; i < 4; ++i) ck[lane + 64 * i] = f2bf(k[i] * rs * C.kvn[i]);
  {
    const float u0 = gelu_f(__uint_as_float(ru.x << 16)), u1 = gelu_f(__uint_as_float(ru.x & 0xffff0000u)), u2 = gelu_f(__uint_as_float(ru.y << 16)), u3 = gelu_f(__uint_as_float(ru.y & 0xffff0000u));
    float v[4] = {gelu_f(__uint_as_float(rv2.x << 16)), gelu_f(__uint_as_float(rv2.x & 0xffff0000u)), gelu_f(__uint_as_float(rv2.y << 16)), gelu_f(__uint_as_float(rv2.y & 0xffff0000u))};
    const float mu = wave_sum(v[0] + v[1] + v[2] + v[3], lane) * (1.f / 256.f);
    float d2 = 0.f;
#pragma unroll
    for (int j = 0; j < 4; ++j) { v[j] -= mu; d2 += v[j] * v[j]; }
    const float rs2 = rsqrtf(wave_sum(d2, lane) * (1.f / 256.f) + 1e-6f);
    u32x2 wu, wv2; wu.x = pk_bf16(u0, u1); wu.y = pk_bf16(u2, u3);
    wv2.x = pk_bf16(v[0] * rs2 * C.g4[0] + C.b4[0], v[1] * rs2 * C.g4[1] + C.b4[1]); wv2.y = pk_bf16(v[2] * rs2 * C.g4[2] + C.b4[2], v[3] * rs2 * C.g4[3] + C.b4[3]);
    *(u32x2*)((bf16_t*)(ows(P) + OFF_UG) + (size_t)r * 256 + 4 * lane) = wu;
    *(u32x2*)((bf16_t*)(ows(P) + OFF_VN) + (size_t)r * 256 + 4 * lane) = wv2;
  }
  if (lane < 32) {
    const float o = r < NLAT ? (pp ? xs * cs.x + xp * cs.y : xs * cs.x - xp * cs.y) : xs;
    int b, p; row_bp(r, b, p);
    ((bf16_t*)(ows(P) + OFF_KR))[((size_t)b * NPOS + p) * 32 + lane] = f2bf(o);
  }
}
DI void sgu_item(const Params& P, int l, int item, unsigned char* lds, int wv) {
  const int tid = otid(wv), wave = tid >> 6, lane = tid & 63, ci = item >> 1, gp = item & 1, r0 = ci * 128;
  const bf16_t* VN = (const bf16_t*)(ows(P) + OFF_VN); const bf16_t* UG = (const bf16_t*)(ows(P) + OFF_UG);
  bf16_t* vT = (bf16_t*)lds;
#pragma unroll
  for (int i = 0; i < 4; ++i) {
    const int e = tid + 512 * i, q = e >> 4, c8 = (e & 15) * 8;
    const u32x4 raw = *(const u32x4*)(VN + (size_t)(r0 + q) * 256 + gp * 128 + c8);
    const unsigned w[4] = {raw.x, raw.y, raw.z, raw.w};
#pragma unroll
    for (int j = 0; j < 4; ++j) { vT[(c8 + 2 * j) * 136 + q] = (bf16_t)(w[j] & 0xffffu); vT[(c8 + 2 * j + 1) * 136 + q] = (bf16_t)(w[j] >> 16); }
  }
  __syncthreads();
  const int ql = lane & 31, hh = lane >> 5, gl = wave >> 2, g = 2 * gp + gl, chl = gl * 64 + (wave & 1) * 32 + ql, pt0 = ((wave >> 1) & 1) * 2;
  const bf16_t* Ws = (const bf16_t*)(ows(P) + OFF_W) + (size_t)l * WL_ELEMS + WO_S + (size_t)g * 128 * 128;
  f32x16 acc[2];
#pragma unroll
  for (int pt = 0; pt < 2; ++pt)
#pragma unroll
    for (int i = 0; i < 16; ++i) acc[pt][i] = 0.f;
#pragma unroll
  for (int s = 0; s < 8; ++s) {
    const bf16x8 bfr = *(const bf16x8*)(vT + chl * 136 + 16 * s + 8 * hh);
#pragma unroll
    for (int pt = 0; pt < 2; ++pt) {
      const bf16x8 afr = *(const bf16x8*)(Ws + (size_t)(32 * (pt0 + pt) + ql) * 128 + 16 * s + 8 * hh);
      acc[pt] = MFMA32(afr, bfr, acc[pt]);
    }
  }
  bf16_t* YC = (bf16_t*)(ows(P) + OFF_H);
  const float* bs = P.in[I_SGBS] + (size_t)l * 512 + g * 128;
  const int chg = gp * 128 + chl;
#pragma unroll
  for (int pt = 0; pt < 2; ++pt)
#pragma unroll
    for (int i = 0; i < 16; ++i) {
      const int p = 32 * (pt0 + pt) + (i & 3) + 8 * (i >> 2) + 4 * hh;
      const float u = bf2f(UG[(size_t)(r0 + p) * 256 + chg]);
      YC[(size_t)(r0 + p) * 1024 + 256 + chg] = f2bf(u * (acc[pt][i] + bs[p]));
    }
  __syncthreads();
}
DI float sconv(const bf16_t* p, int t, int L, float w0, float w1, float w2, float bb) {
  const float a = t > 0 ? bf2f(p[t - 1]) : 0.f, b = bf2f(p[t]), c = t < L - 1 ? bf2f(p[t + 1]) : 0.f;
  return w0 * a + w1 * b + w2 * c + bb;
}
DI void hyena_item(const Params& P, int l, int c, LAS unsigned char* lds, int wv) {
  const int tid = otid(wv);
  LAS cpx* W = (LAS cpx*)lds; LAS cpx* F = W + 8192; LAS float* w3s = (LAS float*)(F + 8192);
  LAS cpx* TW2 = (LAS cpx*)(lds + LDS_TW2_OFF);
  asm volatile("" : "+v"(F), "+v"(w3s), "+v"(TW2));
  const cpx* TW = (const cpx*)(ows(P) + OFF_TW);
#pragma unroll
  for (int i = 0; i < 4; ++i) TW2[tid + 512 * i] = TW[2 * (tid + 512 * i)];
  if (tid < 256) w3s[tid] = P.in[I_HW3][(size_t)l * 64 * 1024 + (tid & 63) * 1024 + (tid >> 6) * 256 + c];
  const float delta = 3.0701134573f + (float)c * ((15.350567286f - 3.0701134573f) / 255.f);
  const float* cwp = P.in[I_HCW] + (size_t)l * 3 * 768; const float* cbp = P.in[I_HCB] + (size_t)l * 768;
  float cw[3][3], cb[3];
#pragma unroll
  for (int k = 0; k < 3; ++k) { cb[k] = cbp[k * 256 + c];
#pragma unroll
    for (int j = 0; j < 3; ++j) cw[k][j] = cwp[j * 768 + k * 256 + c]; }
  const float bias0 = P.in[I_HBIAS][l * 512 + c], bias1 = P.in[I_HBIAS][l * 512 + 256 + c];
  bf16_t* YC = (bf16_t*)(ows(P) + OFF_H);
  __syncthreads();
#ifndef HYP_A
#define HYP_A 1
#endif
#ifndef HYP_B
#define HYP_B 1
#endif
#ifndef HYP_C
#define HYP_C 1
#endif
  for (int repa = 0; repa < HYP_A; ++repa)
  if (l == 0) {
    LAS float* kc = (LAS float*)W; LAS float* vb = kc + 1024; LAS float* v1b = vb + 1024;
    const float* H2C = (const float*)(ows(P) + OFF_H2C) + (size_t)l * 256 * 64;
    if (tid < 256) {
      const int t = tid; float d[4] = {0.f, 0.f, 0.f, 0.f};
      f32x4 hrow[16];
#pragma unroll
      for (int m4 = 0; m4 < 16; ++m4) hrow[m4] = *(const f32x4*)(H2C + t * 64 + 4 * m4);
#pragma unroll
      for (int m4 = 0; m4 < 16; ++m4)
#pragma unroll
        for (int od = 0; od < 4; ++od) { const f32x4 w = *(LAS const f32x4*)(w3s + od * 64 + 4 * m4); d[od] += hrow[m4][0] * w[0] + hrow[m4][1] * w[1] + hrow[m4][2] * w[2] + hrow[m4][3] * w[3]; }
      const float win = __expf(-((float)t / 255.f) * delta) + 0.05f;
      if (t == 0) { kc[255] = (d[0] + d[1]) * win; kc[512 + 255] = (d[2] + d[3]) * win; }
      else { kc[255 + t] = d[0] * win; kc[255 - t] = d[1] * win; kc[512 + 255 + t] = d[2] * win; kc[512 + 255 - t] = d[3] * win; }
    }
    const int cb_ = (tid >> 6) & 3, t0 = (tid & 63) * 4;
    const bf16_t* pbc = (const bf16_t*)(ows(P) + OFF_PTC) + (size_t)cb_ * 768 * 256;
    float x1r[4], x2r[4], vr[4], v1r[4];
    if (tid < 256) {
#pragma unroll
      for (int i = 0; i < 4; ++i) {
        x1r[i] = sconv(pbc + (size_t)c * 256, t0 + i, 256, cw[0][0], cw[0][1], cw[0][2], cb[0]);
        x2r[i] = sconv(pbc + (size_t)(256 + c) * 256, t0 + i, 256, cw[1][0], cw[1][1], cw[1][2], cb[1]);
        vr[i] = sconv(pbc + (size_t)(512 + c) * 256, t0 + i, 256, cw[2][0], cw[2][1], cw[2][2], cb[2]);
        vb[cb_ * 256 + t0 + i] = vr[i];
      }
    }
    __syncthreads();
#pragma unroll
    for (int o = 0; o < 2; ++o) {
      if (tid < 256) {
        LAS const float* src = o ? v1b : vb; LAS const float* kk = kc + o * 512 + 255 + t0;
        float y[4] = {0.f, 0.f, 0.f, 0.f};
        for (int s4 = 0; s4 < 64; ++s4) {
          const f32x4 u4 = *(LAS const f32x4*)(src + cb_ * 256 + 4 * s4);
          float kv[7];
#pragma unroll
          for (int j = 0; j < 7; ++j) kv[j] = kk[j - 3 - 4 * s4];
#pragma unroll
          for (int i = 0; i < 4; ++i)
#pragma unroll
            for (int j = 0; j < 4; ++j) y[i] += kv[3 + i - j] * u4[j];
        }
        if (o == 0) {
#pragma unroll
          for (int i = 0; i < 4; ++i) { v1r[i] = x1r[i] * (y[i] + vr[i] * bias0); v1b[cb_ * 256 + t0 + i] = v1r[i]; }
        } else {
#pragma unroll
          for (int i = 0; i < 4; ++i) YC[(size_t)(NLAT + cb_ * 256 + t0 + i) * 1024 + c] = f2bf(x2r[i] * (y[i] + v1r[i] * bias1));
        }
      }
      __syncthreads();
    }
  }
  for (int repb = 0; repb < HYP_B; ++repb)
  {
    const float* H2 = (const float*)(ows(P) + OFF_H2) + (size_t)l * 4096 * 64;
    LAS float* tile = (LAS float*)W; LAS float* Ff = (LAS float*)F;
    const int tl = tid & 127, od = tid >> 7;
    if (tid < 2) { float z0 = 0.f; asm volatile("" : "+v"(z0)); F[sw(tid * 4096)] = cpx{z0, z0}; }
    f32x4 w4[16];
#pragma unroll
    for (int m4 = 0; m4 < 16; ++m4) w4[m4] = *(LAS const f32x4*)(w3s + od * 64 + 4 * m4);
    f32x4 stg[4];
#pragma unroll
    for (int i = 0; i < 4; ++i) { const int e = tid + 512 * i; stg[i] = *(const f32x4*)(H2 + (size_t)(e >> 4) * 64 + 4 * (e & 15)); }
#pragma unroll 1
    for (int t0 = 0; t0 < 4096; t0 += 128) {
#pragma unroll
      for (int i = 0; i < 4; ++i) { const int e = tid + 512 * i, row = e >> 4, c4 = e & 15; *(LAS f32x4*)(tile + row * 68 + 4 * c4) = stg[i]; }
      if (t0 + 128 < 4096) {
#pragma unroll
        for (int i = 0; i < 4; ++i) { const int e = tid + 512 * i; stg[i] = *(const f32x4*)(H2 + (size_t)(t0 + 128 + (e >> 4)) * 64 + 4 * (e & 15)); }
      }
      __syncthreads();
      float d = 0.f;
#pragma unroll
      for (int m4 = 0; m4 < 16; ++m4) { const f32x4 hv = *(LAS const f32x4*)(tile + tl * 68 + 4 * m4); d += hv[0] * w4[m4][0] + hv[1] * w4[m4][1] + hv[2] * w4[m4][2] + hv[3] * w4[m4][3]; }
      const int t = t0 + tl;
      d *= __expf(-((float)t / 4095.f) * delta) + 0.05f;
      if (t == 0) atomicAdd((float*)(Ff + 2 * sw(0) + (od >> 1)), d);
      else Ff[2 * sw((od & 1) ? 8192 - t : t) + (od >> 1)] = d;
      __syncthreads();
    }
    __syncthreads();
    fft_r2_first(F, TW, tid); __syncthreads();
    fft_r8_dif<1>(F, 12, TW2, tid); __syncthreads(); fft_r8_dif<1>(F, 9, TW2, tid); __syncthreads(); fft_r8_dif<1>(F, 6, TW2, tid); __syncthreads(); fft_r8_dif<1>(F, 3, TW2, tid); __syncthreads();
  }
  for (int bp_ = 0; bp_ < 2 * HYP_C; ++bp_) { const int bp = bp_ & 1;
    float v[8][2];
    const bf16_t* pb0 = (const bf16_t*)(ows(P) + OFF_PT) + (size_t)(2 * bp) * 768 * 4096; const bf16_t* pb1 = pb0 + (size_t)768 * 4096;
#pragma unroll
    for (int i = 0; i < 8; ++i) {
      const int t = tid + 512 * i;
      v[i][0] = sconv(pb0 + (size_t)(512 + c) * 4096, t, 4096, cw[2][0], cw[2][1], cw[2][2], cb[2]);
      v[i][1] = sconv(pb1 + (size_t)(512 + c) * 4096, t, 4096, cw[2][0], cw[2][1], cw[2][2], cb[2]);
    }
#pragma unroll
    for (int o = 0; o < 2; ++o) {
      float gt[8][2];
#pragma unroll
      for (int i = 0; i < 8; ++i) {
        const int t = tid + 512 * i;
        gt[i][0] = sconv(pb0 + (size_t)(o * 256 + c) * 4096, t, 4096, cw[o][0], cw[o][1], cw[o][2], cb[o]);
        gt[i][1] = sconv(pb1 + (size_t)(o * 256 + c) * 4096, t, 4096, cw[o][0], cw[o][1], cw[o][2], cb[o]);
      }
      int t2 = tid; asm volatile("" : "+v"(t2));
      const cpx w12 = TW2[t2];
      {
        cpx lo[8];
#pragma unroll
        for (int q = 0; q < 8; ++q) lo[q] = cpx{v[q][0], v[q][1]};
        bfly8_dif(lo, w12);
#pragma unroll
        for (int q = 0; q < 8; ++q) W[sw(tid + 512 * q)] = lo[q];
        __builtin_amdgcn_sched_barrier(0);
#pragma unroll
        for (int q = 0; q < 8; ++q) lo[q] = cmul(cpx{v[q][0], v[q][1]}, TW[t2 + 512 * q]);
        bfly8_dif(lo, w12);
#pragma unroll
        for (int q = 0; q < 8; ++q) W[sw(4096 + tid + 512 * q)] = lo[q];
      }
      __syncthreads();
      fft_r8_dif<1>(W, 9, TW2, tid); __syncthreads(); fft_r8_dif<1>(W, 6, TW2, tid); __syncthreads(); fft_r8_dif<1>(W, 3, TW2, tid); __syncthreads();
      spec_mul(W, F, o, tid); __syncthreads();
      ifft_r8_dit<1>(W, 3, TW2, tid); __syncthreads(); ifft_r8_dit<1>(W, 6, TW2, tid); __syncthreads(); ifft_r8_dit<1>(W, 9, TW2, tid); __syncthreads();
      const float bo = o ? bias1 : bias0;
      cpx rlo[8], rup[8];
#pragma unroll
      for (int q = 0; q < 8; ++q) rlo[q] = W[sw(tid + 512 * q)];
      bfly8_dit(rlo, w12);
      __builtin_amdgcn_sched_barrier(0);
#pragma unroll
      for (int q = 0; q < 8; ++q) rup[q] = W[sw(4096 + tid + 512 * q)];
      bfly8_dit(rup, w12);
      int tq = tid; asm volatile("" : "+v"(tq));
#pragma unroll
      for (int i = 0; i < 8; ++i) {
        const int t = tid + 512 * i;
        cpx r = cadd(rlo[i], cmulc(rup[i], TW[tq + 512 * i])); r.x *= (1.f / 8192.f); r.y *= (1.f / 8192.f);
        const float g0 = gt[i][0], g1 = gt[i][1];
        if (o == 0) { v[i][0] = g0 * (r.x + v[i][0] * bo); v[i][1] = g1 * (r.y + v[i][1] * bo); }
        else {
          YC[(size_t)((2 * bp) * 4096 + t) * 1024 + c] = f2bf(g0 * (r.x + v[i][0] * bo));
          YC[(size_t)((2 * bp + 1) * 4096 + t) * 1024 + c] = f2bf(g1 * (r.y + v[i][1] * bo));
        }
      }
      __syncthreads();
#ifdef HYP_FFT
      for (int rp = 0; rp < HYP_FFT; ++rp) {
        fft_r8_dif<1>(W, 12, TW2, tid); __syncthreads(); fft_r8_dif<1>(W, 9, TW2, tid); __syncthreads(); fft_r8_dif<1>(W, 6, TW2, tid); __syncthreads(); fft_r8_dif<1>(W, 3, TW2, tid); __syncthreads();
        ifft_r8_dit<1>(W, 3, TW2, tid); __syncthreads(); ifft_r8_dit<1>(W, 6, TW2, tid); __syncthreads(); ifft_r8_dit<1>(W, 9, TW2, tid); __syncthreads(); ifft_r8_dit<1>(W, 12, TW2, tid); __syncthreads();
      }
#endif
    }
  }
}
constexpr int AT_KROW = 104, AT_VROW = 72, AT_STAGE = (64 * AT_KROW + 64 * AT_VROW) * 2;
DI void attn_item(const Params& P, int item, unsigned char* lds, int wv) {
  const int tid = otid(wv), wave = tid >> 6, lane = tid & 63, ql = lane & 31, hh = lane >> 5;
  const int qb = item % 17, bh = item / 17, b = bh >> 3, h = bh & 7;
  const int nt = qb == 0 ? 4 : 68;
  const int pq = qb * 256 + wave * 32 + ql;
  const bf16_t* qptr = (const bf16_t*)(ows(P) + OFF_Q) + ((size_t)bh * NPOS + pq) * 96 + 8 * hh;
  bf16x8 qf[6];
#pragma unroll
  for (int s = 0; s < 6; ++s) qf[s] = *(const bf16x8*)(qptr + 16 * s);
  const bf16_t* kn_src = (const bf16_t*)(ows(P) + OFF_KN) + ((size_t)bh * NPOS + (tid >> 3)) * 64 + (tid & 7) * 8;
  const bf16_t* kr_src = (const bf16_t*)(ows(P) + OFF_KR) + ((size_t)b * NPOS + ((tid & 255) >> 2)) * 32 + (tid & 3) * 8;
  const bf16_t* vt_src = (const bf16_t*)(ows(P) + OFF_VT) + ((size_t)bh * 64 + (tid >> 3)) * NPOS + (tid & 7) * 8;
  const int kn_dst = (tid >> 3) * AT_KROW + (tid & 7) * 8, kr_dst = ((tid & 255) >> 2) * AT_KROW + 64 + (tid & 3) * 8, vt_dst = 64 * AT_KROW + (tid >> 3) * AT_VROW + (tid & 7) * 8;
  u32x4 rk, rr = {0, 0, 0, 0}, rv;
  rk = *(const u32x4*)kn_src; if (tid < 256) rr = *(const u32x4*)kr_src; rv = *(const u32x4*)vt_src;
  { bf16_t* S0 = (bf16_t*)lds; *(u32x4*)(S0 + kn_dst) = rk; if (tid < 256) *(u32x4*)(S0 + kr_dst) = rr; *(u32x4*)(S0 + vt_dst) = rv; }
  __syncthreads();
  f32x16 o0, o1;
#pragma unroll
  for (int i = 0; i < 16; ++i) { o0[i] = 0.f; o1[i] = 0.f; }
  float mrun = -1e30f, lrun = 0.f;
  for (int t = 0; t < nt; ++t) {
    if (t + 1 < nt) { rk = *(const u32x4*)(kn_src + (size_t)(t + 1) * 64 * 64); if (tid < 256) rr = *(const u32x4*)(kr_src + (size_t)(t + 1) * 64 * 32); rv = *(const u32x4*)(vt_src + (t + 1) * 64); }
    const bf16_t* Kl = (const bf16_t*)(lds + (t & 1) * AT_STAGE); const bf16_t* Vl = Kl + 64 * AT_KROW;
    f32x16 s0, s1;
#pragma unroll
    for (int i = 0; i < 16; ++i) { s0[i] = 0.f; s1[i] = 0.f; }
#pragma unroll
    for (int s = 0; s < 6; ++s) {
      const bf16x8 a0 = *(const bf16x8*)(Kl + ql * AT_KROW + 16 * s + 8 * hh), a1 = *(const bf16x8*)(Kl + (32 + ql) * AT_KROW + 16 * s + 8 * hh);
      s0 = MFMA32(a0, qf[s], s0); s1 = MFMA32(a1, qf[s], s1);
    }
    float mx = s0[0];
#pragma unroll
    for (int i = 0; i < 16; ++i) mx = fmaxf(mx, fmaxf(s0[i], s1[i]));
    const float mxo = xshfl(mx, lane, 32);
    if (t == 0) mrun = fmaxf(mx, mxo);
    float ps = 0.f;
#pragma unroll
    for (int i = 0; i < 16; ++i) { s0[i] = __builtin_amdgcn_exp2f(s0[i] - mrun); s1[i] = __builtin_amdgcn_exp2f(s1[i] - mrun); ps += s0[i] + s1[i]; }
    lrun += ps;
#pragma unroll
    for (int kt = 0; kt < 2; ++kt)
#pragma unroll
      for (int s = 0; s < 2; ++s) {
        const f32x16& sx = kt ? s1 : s0;
        u32x4 pw; pw.x = pk_bf16(sx[8 * s], sx[8 * s + 1]); pw.y = pk_bf16(sx[8 * s + 2], sx[8 * s + 3]); pw.z = pk_bf16(sx[8 * s + 4], sx[8 * s + 5]); pw.w = pk_bf16(sx[8 * s + 6], sx[8 * s + 7]);
        const bf16x8 pb = __builtin_bit_cast(bf16x8, pw);
        const int ko = 32 * kt + 16 * s + 4 * hh;
        const s16x4 l0 = *(const s16x4*)(Vl + ql * AT_VROW + ko), h0 = *(const s16x4*)(Vl + ql * AT_VROW + ko + 8);
        const s16x4 l1 = *(const s16x4*)(Vl + (32 + ql) * AT_VROW + ko), h1 = *(const s16x4*)(Vl + (32 + ql) * AT_VROW + ko + 8);
        const bf16x8 av0 = __builtin_shufflevector(l0, h0, 0, 1, 2, 3, 4, 5, 6, 7), av1 = __builtin_shufflevector(l1, h1, 0, 1, 2, 3, 4, 5, 6, 7);
        o0 = MFMA32(av0, pb, o0); o1 = MFMA32(av1, pb, o1);
      }
    {
      const float mnew = fmaxf(mrun, fmaxf(mx, mxo));
      if (__builtin_amdgcn_ballot_w64(mnew > mrun + 6.f) != 0ull) {
        const float alpha = __builtin_amdgcn_exp2f(mrun - mnew);
        lrun *= alpha;
#pragma unroll
        for (int i = 0; i < 16; ++i) { o0[i] *= alpha; o1[i] *= alpha; }
        mrun = mnew;
      }
    }
    if (t + 1 < nt) { bf16_t* S1 = (bf16_t*)(lds + ((t + 1) & 1) * AT_STAGE); *(u32x4*)(S1 + kn_dst) = rk; if (tid < 256) *(u32x4*)(S1 + kr_dst) = rr; *(u32x4*)(S1 + vt_dst) = rv; }
    __syncthreads();
  }
  const float linv = 1.f / (lrun + xshfl(lrun, lane, 32));
  const int rout = pq < 256 ? NLAT + b * 256 + pq : b * 4096 + pq - 256;
  bf16_t* yo = (bf16_t*)(ows(P) + OFF_H) + (size_t)rout * 1024 + 512 + h * 64 + 4 * hh;
#pragma unroll
  for (int g4 = 0; g4 < 4; ++g4) {
    u32x2 w0, w1;
    w0.x = pk_bf16(o0[4 * g4] * linv, o0[4 * g4 + 1] * linv); w0.y = pk_bf16(o0[4 * g4 + 2] * linv, o0[4 * g4 + 3] * linv);
    w1.x = pk_bf16(o1[4 * g4] * linv, o1[4 * g4 + 1] * linv); w1.y = pk_bf16(o1[4 * g4 + 2] * linv, o1[4 * g4 + 3] * linv);
    *(u32x2*)(yo + 8 * g4) = w0; *(u32x2*)(yo + 32 + 8 * g4) = w1;
  }
}
#ifndef EN_HY
#define EN_HY 1
#endif
#ifndef EN_SG
#define EN_SG 1
#endif
#ifndef EN_AT
#define EN_AT 1
#endif
#ifndef REP_GEMM
#define REP_GEMM 1
#endif
#ifndef REP_ATTN
#define REP_ATTN 1
#endif
#ifndef REP_HY
#define REP_HY 1
#endif
#ifndef REP_P0
#define REP_P0 1
#endif
#ifndef REP_PREP
#define REP_PREP 1
#endif
#ifndef REP_SGU
#define REP_SGU 1
#endif
#ifndef REP_SYNC
#define REP_SYNC 1
#endif
#ifndef REP_UP
#define REP_UP 1
#endif
#ifndef REP_DOWN
#define REP_DOWN 1
#endif
#ifndef REP_PROJ
#define REP_PROJ 1
#endif
#ifndef REP_OUT
#define REP_OUT 1
#endif
#ifndef REP_QKV
#define REP_QKV 1
#endif
template <class Epi> DI void run_gemm(unsigned char* lds, const bf16_t* A, const bf16_t* Bt, int N, int K, const Epi& E, int wv, int M = MTOT, int reps = 1, int cshift = 0) {
  pg8::Gemm g; g.A = A; g.Bt = Bt; g.M = M; g.N = N; g.K = K;
  pg8::StaticOrder S; S.init(M, N, (int)gridDim.x, (int)((blockIdx.x + cshift) % gridDim.x)); S.ntk = K / 64;
  for (int rep = 0; rep < REP_GEMM * reps; ++rep) { Epi E2 = E; E2.wv = wv; if (rep + 1 < REP_GEMM * reps) E2.kill(); pg8::gemm_phase<Epi, pg8::StaticOrder, false>((LAS unsigned char*)lds, g, S, E2, nullptr, wv); }
}
template <class Epi> DI void run_gemm_split(unsigned char* lds, const bf16_t* A, const bf16_t* Bt, int K, int S_, const Epi& E, int wv, int reps = 1) {
  pg8::Gemm g; g.A = A; g.Bt = Bt; g.M = MTOT; g.N = 1024; g.K = K;
  pg8::SplitOrder S; S.init(K, S_, (int)gridDim.x, (int)blockIdx.x);
  for (int rep = 0; rep < REP_GEMM * reps; ++rep) { Epi E2 = E; E2.wv = wv; E2.ksub = K / S_; if (rep + 1 < REP_GEMM * reps) E2.kill(); pg8::gemm_phase<Epi, pg8::SplitOrder, false>((LAS unsigned char*)lds, g, S, E2, nullptr, wv); }
}
DI void zero_cols(const Params& P, int c0, int wv) {
  for (size_t i = (size_t)blockIdx.x * 512 + otid(wv); i < (size_t)MTOT * 32; i += (size_t)gridDim.x * 512) {
    const size_t r = i >> 5, ch = i & 31; *(u32x4*)((bf16_t*)(P.ws + OFF_H) + r * 1024 + c0 + ch * 8) = (u32x4){0, 0, 0, 0}; }
}
__global__ void __launch_bounds__(512) fwd_megakernel(Params P) {
  cg::grid_group grid = cg::this_grid();
  extern __shared__ __attribute__((aligned(16))) unsigned char lds[];
  const int wv = __builtin_amdgcn_readfirstlane(threadIdx.x >> 6);
  gchar* ws = ows(P);
  bf16_t* H = (bf16_t*)(ws + OFF_H); bf16_t* AFF = (bf16_t*)(ws + OFF_R1);
  if (blockIdx.x == 0) for (int i = threadIdx.x; i < XCD_BAR_WORDS; i += 512) ((unsigned*)(P.ws + OFF_BAR))[i] = 0u;
  if (threadIdx.x < 4) ((LAS unsigned*)((LAS unsigned char*)lds + LDS_ST_OFF))[threadIdx.x] = 0u;
  grid.sync();
  if (threadIdx.x == 0) (void)xb_add(&((unsigned*)(P.ws + OFF_BAR))[XB_XCNT(xb_xcc_id())], 1u);
  for (int rep = 0; rep < REP_P0; ++rep) phase0(P, lds, wv);
  gsync(P, lds, wv);
  for (int l = 0; l < 2; ++l) {
    const bf16_t* WL = (const bf16_t*)(ws + OFF_W) + (size_t)l * WL_ELEMS;
    const float* mod = (const float*)(ws + OFF_MOD) + (size_t)l * 5 * 9216;
    for (int rep = 0; rep < REP_PREP; ++rep) { if (l == 0) prep_phase<true>(P, l, 0, wv); else prep_phase<false>(P, l, 0, wv, MTOT, 8); }
    for (int rep = 0; rep < REP_SYNC; ++rep) gsync(P, lds, wv);
    { EpiSwiglu E; E.O = AFF; run_gemm(lds, H, WL + WO_UP1, 5632, 1024, E, wv, MTOT, REP_UP); }
    for (int rep = 0; rep < REP_SYNC; ++rep) gsync(P, lds, wv);
    { EpiResid E; E.xb = (bf16_t*)(ws + OFF_XB); E.xc = (float*)(ws + OFF_XC); E.part = (float*)(ws + OFF_PART); E.mod = mod + 2 * 1024; E.coef = 0.5f; run_gemm_split(lds, AFF, WL + WO_D1, DFF, 8, E, wv, REP_DOWN); }
    for (int rep = 0; rep < REP_SYNC; ++rep) gsync(P, lds, wv);
    for (int rep = 0; rep < REP_PREP; ++rep) prep_phase<false>(P, l, 3, wv, MTOT, 8);
    for (int rep = 0; rep < REP_SYNC; ++rep) gsync(P, lds, wv);
    { EpiProj E; E.ws = ws; run_gemm(lds, H, WL + WO_IN, NINP, 1024, E, wv, MTOT, REP_PROJ); }
    for (int rep = 0; rep < REP_SYNC; ++rep) gsync(P, lds, wv);
#if EN_HY
    for (int c = blockIdx.x; c < 256 * REP_HY; c += gridDim.x) hyena_item(P, l, c & 255, (LAS unsigned char*)lds, wv);
#else
    zero_cols(P, 0, wv);
#endif
    __syncthreads();
    for (int rep = 0; rep < REP_SGU; ++rep) { const MixC mc = mixprep_consts(P, l, wv);
    for (int r = blockIdx.x * 8 + wv; r < MTOT; r += gridDim.x * 16) { mixprep_row(P, l, r, wv, mc); if (r + (int)gridDim.x * 8 < MTOT) mixprep_row(P, l, r + gridDim.x * 8, wv, mc); } }
    for (int rep = 0; rep < REP_SYNC; ++rep) gsync(P, lds, wv);
#if EN_SG
    { const int nsg = l == 1 ? 256 : 272;
      for (int it = gridDim.x - 1 - blockIdx.x; it < nsg * REP_SGU; it += gridDim.x) sgu_item(P, l, it % nsg, lds, wv); }
#else
    zero_cols(P, 256, wv);
#endif
    { EpiQ E; E.ws = ws; run_gemm(lds, (const bf16_t*)(ws + OFF_CQN), WL + WO_UQ, 768, 384, E, wv, MTOT, REP_QKV); }
    { EpiKV E; E.ws = ws; run_gemm(lds, (const bf16_t*)(ws + OFF_CKVN), WL + WO_UKV, 1024, 256, E, wv, MTOT, REP_QKV, 52); }
    for (int rep = 0; rep < REP_SYNC; ++rep) gsync(P, lds, wv);
#if EN_AT
    for (int it0 = blockIdx.x; it0 < 544 * REP_ATTN; it0 += gridDim.x) { const int it = it0 % 544;
      int item;
      if (it < 512) { const int c = it & 255, k = it >> 8, xcd = c & 7, slot = c >> 3; item = (16 * k + 2 * xcd + (slot >> 4)) * 17 + 1 + (slot & 15); }
      else item = (it - 512) * 17;
      if (l == 1 && it >= 512) continue; attn_item(P, item, lds, wv); }
#else
    zero_cols(P, 512, wv); zero_cols(P, 768, wv);
#endif
    for (int rep = 0; rep < REP_SYNC; ++rep) gsync(P, lds, wv);
    { EpiResid E; E.xb = (bf16_t*)(ws + OFF_XB); E.xc = (float*)(ws + OFF_XC); E.part = (float*)(ws + OFF_PART); E.mod = mod + 5 * 1024; E.coef = 1.0f; if (l == 1) run_gemm(lds, H, WL + WO_OUT, 1024, 1024, E, wv, NLAT, REP_OUT); else run_gemm_split(lds, H, WL + WO_OUT, 1024, 4, E, wv, REP_OUT); }
    for (int rep = 0; rep < REP_SYNC; ++rep) gsync(P, lds, wv);
    for (int rep = 0; rep < REP_PREP; ++rep) prep_phase<false>(P, l, 6, wv, l == 1 ? NLAT : MTOT, l == 1 ? 0 : 4);
    for (int rep = 0; rep < REP_SYNC; ++rep) gsync(P, lds, wv);
    { EpiSwiglu E; E.O = AFF; run_gemm(lds, H, WL + WO_UP2, 5632, 1024, E, wv, l == 1 ? NLAT : MTOT); }
    for (int rep = 0; rep < REP_SYNC; ++rep) gsync(P, lds, wv);
    { EpiResid E; E.xb = (bf16_t*)(ws + OFF_XB); E.xc = (float*)(ws + OFF_XC); E.part = (float*)(ws + OFF_PART); E.mod = mod + 8 * 1024; E.coef = 0.5f; if (l == 1) run_gemm(lds, AFF, WL + WO_D2, 1024, DFF, E, wv, NLAT); else run_gemm_split(lds, AFF, WL + WO_D2, DFF, 8, E, wv); }
    for (int rep = 0; rep < REP_SYNC; ++rep) gsync(P, lds, wv);
  }
  final_phase(P, wv);
}

extern "C" void kernel_launch(void* const* d_in, const int* in_sizes, int n_in, void* d_out, int out_size, void* d_ws, size_t ws_size, hipStream_t stream) {
  constexpr size_t kDynLds = 150528;
  static int grid_blocks = 0;
  if (!grid_blocks) {
    (void)hipFuncSetAttribute((const void*)fwd_megakernel, hipFuncAttributeMaxDynamicSharedMemorySize, (int)kDynLds);
    int dev = 0, cus = 0, per_cu = 0;
    (void)hipGetDevice(&dev);
    (void)hipDeviceGetAttribute(&cus, hipDeviceAttributeMultiprocessorCount, dev);
    (void)hipOccupancyMaxActiveBlocksPerMultiprocessor(&per_cu, fwd_megakernel, 512, kDynLds);
    grid_blocks = cus > 0 ? cus : 256;
    if (ws_size < WS_END) fprintf(stderr, "workspace too small: %zu < %zu\n", ws_size, (size_t)WS_END);
  }
  Params p{};
  for (int i = 0; i < 32 && i < n_in; ++i) p.in[i] = (const float*)d_in[i];
  p.out = (float*)d_out; p.ws = (char*)d_ws;
  void* args[] = {&p};
  hipError_t e = hipLaunchCooperativeKernel((void*)fwd_megakernel, dim3(grid_blocks), dim3(512), args, kDynLds, stream);
  if (e != hipSuccess) fprintf(stderr, "cooperative launch failed: %s (grid %d)\n", hipGetErrorString(e), grid_blocks);
}
```
